# Optimizing an MI355X kernel written in HIP

```python
import math
import jax, jax.numpy as jnp
from jax import lax
import numpy as np

D_MODEL = 2048
BATCH = 8
SEQ = 2048
DEPTH = 2

N_A_LAYERS = DEPTH // 2
N_B_LAYERS = DEPTH - N_A_LAYERS
GLA_HEADS = 4
GLA_DK = D_MODEL // 2
GLA_DV = D_MODEL
GLA_HK = GLA_DK // GLA_HEADS
GLA_HV = GLA_DV // GLA_HEADS
GATE_RANK = 16
GATE_TAU = 16.0
GLA_CHUNK = 64
GLA_IN = 2 * GLA_DK + 2 * GLA_DV + GATE_RANK
DIFF_HEADS = 8
DIFF_HD = D_MODEL // DIFF_HEADS // 2
Q_BLOCK = 128
LAMBDA_INIT_STD = 0.1
REL_BUCKETS = 32
REL_MAX_EXACT = REL_BUCKETS // 2
REL_MAX_DIST = 128
D_FF = ((8 * D_MODEL // 3 + 255) // 256) * 256
EPS = 1e-6

kernel_name = "yoco_gla_diffattn_hybrid"


def rmsnorm(x, g):
    xf = x.astype(jnp.float32)
    y = xf * lax.rsqrt(jnp.mean(xf * xf, axis=-1, keepdims=True) + EPS)
    return (y * g.astype(jnp.float32)).astype(x.dtype)


def swiglu(h, w_gate_up, w_down):
    gate, up = jnp.split(h @ w_gate_up, 2, axis=-1)
    return (jax.nn.silu(gate) * up) @ w_down


def _to_chunks(t, n_heads, head_dim):
    b, s, _ = t.shape
    return t.reshape(b, s // GLA_CHUNK, GLA_CHUNK, n_heads, head_dim).transpose(0, 3, 1, 2, 4)


def gla_mixer(h, w_in, w_fgate, b_fgate, g_norm, w_out):
    b, s, _ = h.shape
    f32 = jnp.float32
    proj = h @ w_in
    q, k, v, r, g_lr = jnp.split(
        proj, [GLA_DK, 2 * GLA_DK, 2 * GLA_DK + GLA_DV, 2 * GLA_DK + 2 * GLA_DV], axis=-1)
    log_a = jax.nn.log_sigmoid((g_lr @ w_fgate + b_fgate).astype(f32)) / GATE_TAU
    q = _to_chunks(q.astype(f32), GLA_HEADS, GLA_HK) * (GLA_HK ** -0.5)
    k = _to_chunks(k.astype(f32), GLA_HEADS, GLA_HK)
    v = _to_chunks(v.astype(f32), GLA_HEADS, GLA_HV)
    bcum = jnp.cumsum(_to_chunks(log_a, GLA_HEADS, GLA_HK), axis=-2)
    b_last = bcum[..., -1:, :]
    q_dec = q * jnp.exp(bcum)
    k_inv = k * jnp.exp(-bcum)
    k_end = k * jnp.exp(b_last - bcum)
    causal = jnp.tril(jnp.ones((GLA_CHUNK, GLA_CHUNK), dtype=bool))
    att = jnp.where(causal, jnp.einsum('bhncd,bhnjd->bhncj', q_dec, k_inv), 0.0)
    o_intra = jnp.einsum('bhncj,bhnje->bhnce', att, v)

    def step(state, xs):
        qd, ke, vc, dec = xs
        o = jnp.einsum('bhcd,bhde->bhce', qd, state)
        state = dec[..., None] * state + jnp.einsum('bhcd,bhce->bhde', ke, vc)
        return state, o

    xs = (jnp.moveaxis(q_dec, 2, 0), jnp.moveaxis(k_end, 2, 0), jnp.moveaxis(v, 2, 0),
          jnp.moveaxis(jnp.exp(b_last[..., 0, :]), 2, 0))
    state0 = jnp.zeros((b, GLA_HEADS, GLA_HK, GLA_HV), f32)
    _, o_inter = lax.scan(step, state0, xs)
    o = o_intra + jnp.moveaxis(o_inter, 0, 2)
    o = o.transpose(0, 2, 3, 1, 4).reshape(b, s, GLA_HEADS, GLA_HV)
    gate = jax.nn.silu(r.astype(f32)).reshape(b, s, GLA_HEADS, GLA_HV)
    o = rmsnorm(o, g_norm) * gate
    return o.reshape(b, s, GLA_DV).astype(h.dtype) @ w_out


def t5_bucket(dist):
    n = jnp.maximum(dist, 0)
    nf = jnp.maximum(n, 1).astype(jnp.float32)
    large = REL_MAX_EXACT + (jnp.log(nf / REL_MAX_EXACT) / math.log(REL_MAX_DIST / REL_MAX_EXACT)
                             * (REL_BUCKETS - REL_MAX_EXACT)).astype(jnp.int32)
    large = jnp.minimum(large, REL_BUCKETS - 1)
    return jnp.where(n < REL_MAX_EXACT, n, large)


def shared_kv(x, kv_norm_g, w_kv):
    b, s, _ = x.shape
    k, v = jnp.split(rmsnorm(x, kv_norm_g) @ w_kv, 2, axis=-1)
    k = k.astype(jnp.float32).reshape(b, s, DIFF_HEADS, 2, DIFF_HD).transpose(0, 2, 3, 1, 4)
    v = v.astype(jnp.float32).reshape(b, s, DIFF_HEADS, 2 * DIFF_HD).transpose(0, 2, 1, 3)
    return k, v


def diff_mixer(h, k_sh, v_sh, rel_bias_table, w_q, lam_q1, lam_k1, lam_q2, lam_k2,
               subln_g, w_out, lambda_init):
    b, s, _ = h.shape
    f32 = jnp.float32
    q = (h @ w_q).astype(f32).reshape(b, s, DIFF_HEADS, 2, DIFF_HD) * (DIFF_HD ** -0.5)
    n_blk = s // Q_BLOCK
    q_blocks = q.reshape(b, n_blk, Q_BLOCK, DIFF_HEADS, 2, DIFF_HD).transpose(1, 0, 3, 4, 2, 5)
    lam = (jnp.exp(jnp.sum(lam_q1.astype(f32) * lam_k1.astype(f32)))
           - jnp.exp(jnp.sum(lam_q2.astype(f32) * lam_k2.astype(f32))) + lambda_init)
    table = rel_bias_table.astype(f32)
    k_pos = jnp.arange(s)

    def attend(args):
        qb, start = args
        scores = jnp.einsum('bhmqd,bhmkd->bhmqk', qb, k_sh)
        dist = (start + jnp.arange(Q_BLOCK))[:, None] - k_pos[None, :]
        bias = jnp.take(table, t5_bucket(dist), axis=0)
        scores = scores + jnp.transpose(bias, (2, 0, 1))[None, :, None]
        scores = jnp.where(dist >= 0, scores, -jnp.inf)
        p = jax.nn.softmax(scores, axis=-1)
        a = p[:, :, 0] - lam * p[:, :, 1]
        return jnp.einsum('bhqk,bhke->bhqe', a, v_sh)

    o = lax.map(attend, (q_blocks, jnp.arange(n_blk) * Q_BLOCK))
    o = o.transpose(1, 0, 3, 2, 4).reshape(b, s, DIFF_HEADS, 2 * DIFF_HD)
    o = rmsnorm(o, subln_g) * (1.0 - lambda_init)
    return o.reshape(b, s, D_MODEL).astype(h.dtype) @ w_out


def setup_inputs(seed: int = 0) -> dict:
    key = jax.random.key(seed)
    ks = jax.random.split(key, 24)
    f32 = jnp.float32

    def nrm(k, shape, scale):
        return jax.random.normal(k, shape, f32) * scale

    def gain(k, shape):
        return 1.0 + 0.05 * jax.random.normal(k, shape, f32)

    return {
        "x": nrm(ks[0], (BATCH, SEQ, D_MODEL), 1.0),
        "rel_bias_table": nrm(ks[1], (REL_BUCKETS, DIFF_HEADS), 0.5),
        "kv_norm_g": gain(ks[2], (D_MODEL,)),
        "w_kv": nrm(ks[3], (D_MODEL, 2 * D_MODEL), D_MODEL ** -0.5),
        "gla_w_in": nrm(ks[4], (N_A_LAYERS, D_MODEL, GLA_IN), D_MODEL ** -0.5),
        "gla_w_fgate": nrm(ks[5], (N_A_LAYERS, GATE_RANK, GLA_DK), GATE_RANK ** -0.5),
        "gla_b_fgate": nrm(ks[6], (N_A_LAYERS, GLA_DK), 0.1),
        "gla_norm_g": gain(ks[7], (N_A_LAYERS, GLA_HV)),
        "gla_w_out": nrm(ks[8], (N_A_LAYERS, GLA_DV, D_MODEL), GLA_DV ** -0.5),
        "diff_w_q": nrm(ks[9], (N_B_LAYERS, D_MODEL, D_MODEL), D_MODEL ** -0.5),
        "diff_lam_q1": nrm(ks[10], (N_B_LAYERS, DIFF_HD), LAMBDA_INIT_STD),
        "diff_lam_k1": nrm(ks[11], (N_B_LAYERS, DIFF_HD), LAMBDA_INIT_STD),
        "diff_lam_q2": nrm(ks[12], (N_B_LAYERS, DIFF_HD), LAMBDA_INIT_STD),
        "diff_lam_k2": nrm(ks[13], (N_B_LAYERS, DIFF_HD), LAMBDA_INIT_STD),
        "diff_subln_g": gain(ks[14], (N_B_LAYERS, 2 * DIFF_HD)),
        "diff_w_out": nrm(ks[15], (N_B_LAYERS, D_MODEL, D_MODEL), D_MODEL ** -0.5),
        "pre_mix_g": gain(ks[16], (DEPTH, D_MODEL)),
        "post_mix_g": gain(ks[17], (DEPTH, D_MODEL)),
        "pre_ffn_g": gain(ks[18], (DEPTH, D_MODEL)),
        "post_ffn_g": gain(ks[19], (DEPTH, D_MODEL)),
        "ffn_w_gate_up": nrm(ks[20], (DEPTH, D_MODEL, 2 * D_FF), D_MODEL ** -0.5),
        "ffn_w_down": nrm(ks[21], (DEPTH, D_FF, D_MODEL), D_FF ** -0.5),
    }


def reference(x, rel_bias_table, kv_norm_g, w_kv, gla_w_in, gla_w_fgate, gla_b_fgate,
              gla_norm_g, gla_w_out, diff_w_q, diff_lam_q1, diff_lam_k1, diff_lam_q2,
              diff_lam_k2, diff_subln_g, diff_w_out, pre_mix_g, post_mix_g, pre_ffn_g,
              post_ffn_g, ffn_w_gate_up, ffn_w_down):
    k_sh = None
    v_sh = None
    for i in range(DEPTH):
        h = rmsnorm(x, pre_mix_g[i])
        if i < N_A_LAYERS:
            mix = gla_mixer(h, gla_w_in[i], gla_w_fgate[i], gla_b_fgate[i],
                            gla_norm_g[i], gla_w_out[i])
        else:
            if i == N_A_LAYERS:
                k_sh, v_sh = shared_kv(x, kv_norm_g, w_kv)
            j = i - N_A_LAYERS
            lambda_init = 0.8 - 0.6 * math.exp(-0.3 * i)
            mix = diff_mixer(h, k_sh, v_sh, rel_bias_table, diff_w_q[j], diff_lam_q1[j],
                             diff_lam_k1[j], diff_lam_q2[j], diff_lam_k2[j], diff_subln_g[j],
                             diff_w_out[j], lambda_init)
        x = x + rmsnorm(mix, post_mix_g[i])
        f = swiglu(rmsnorm(x, pre_ffn_g[i]), ffn_w_gate_up[i], ffn_w_down[i])
        x = x + rmsnorm(f, post_ffn_g[i])
    return x
```

```cpp
#include <hip/hip_runtime.h>
#include <hip/hip_cooperative_groups.h>
#include <cstdio>
#include <cstdint>
#include <cmath>
namespace cg = cooperative_groups;
namespace pg8 {
#define PG8_LAS __attribute__((address_space(3)))
typedef unsigned short bf16_t;
typedef short bf16x8 __attribute__((ext_vector_type(8)));
typedef float f32x4 __attribute__((ext_vector_type(4)));
typedef unsigned u32x4 __attribute__((ext_vector_type(4)));
constexpr int BM = 256, BK = 64, HALF = 128, HTB = HALF * BK * 2  , STAGE_BYTES = 8 * HTB, NXCD = 8, WGM = 8;

__host__ __device__ __forceinline__ int lds_byte(int r, int c) { const int st = (r >> 4) * 2 + (c >> 5), rr = r & 15, cc = c & 31, ob = rr * 64 + cc * 2; return st * 1024 + (ob ^ (((ob >> 9) & 1) << 5)); }
__host__ __device__ __forceinline__ void stage_rc(int b, int& R, int& C) { const int st = b / 1024, sb = b % 1024, swz = sb ^ (((sb >> 9) & 1) << 5); R = (st >> 1) * 16 + swz / 64; C = (st & 1) * 32 + (swz % 64) / 2; }
__host__ __device__ __forceinline__ int perm32(int rho) { const int n = rho >> 4, i = rho & 15; return 8 * (i >> 2) + 4 * n + (i & 3); }

struct Unit { int pm, pn; };
struct Gemm { const bf16_t* A; const bf16_t* Bt; int M, N, K; };

struct StaticOrder {
    int nM, nN, nwg, G, c;
    __host__ __device__ void init(int M, int N, int G_, int c_) { nM = M / BM; nN = N / BM; nwg = nM * nN; G = G_; c = c_; }
    __host__ __device__ bool next(int i, Unit& u) const {
        const long L = (long)i * G + c; if (L >= nwg) return false;
        int wgid = (int)L; { const int q = nwg / NXCD, r = nwg % NXCD, xcd = wgid % NXCD, off = wgid / NXCD; wgid = (xcd < r ? xcd * (q + 1) : r * (q + 1) + (xcd - r) * q) + off; }
        const int nig = WGM * nN, gid = wgid / nig, fm = gid * WGM, gsz = (nM - fm) < WGM ? (nM - fm) : WGM;
        u.pm = fm + ((wgid % nig) % gsz); u.pn = (wgid % nig) / gsz; return true;
    }
    __device__ __forceinline__ void a_ready(const Unit&) const {}
    __device__ __forceinline__ void done(const Unit&) const {}
};

__device__ __forceinline__ unsigned cvt_pk_bf16(float lo, float hi) { unsigned r; asm volatile("v_cvt_pk_bf16_f32 %0, %1, %2" : "=v"(r) : "v"(lo), "v"(hi)); return r; }
typedef float f32x2 __attribute__((ext_vector_type(2)));
__device__ __forceinline__ f32x2 gelu_pk(f32x2 v) {
    const f32x2 av = __builtin_elementwise_abs(v), d = av * 0.2316418882f + 1.0f;
    f32x2 t; t.x = __builtin_amdgcn_rcpf(d.x); t.y = __builtin_amdgcn_rcpf(d.y);
    f32x2 q = t * 0.5307027145f + (-0.7265760135f); q = q * t + 0.7107068705f; q = q * t + (-0.142248368f); q = q * t + 0.127414796f; q = q * t;
    const f32x2 s = (v * v) * (-0.72134752044f);
    f32x2 e; e.x = __builtin_amdgcn_exp2f(s.x); e.y = __builtin_amdgcn_exp2f(s.y);
    const f32x2 m = v * (q * e), r = v - m;
    f32x2 o; o.x = v.x < 0.f ? m.x : r.x; o.y = v.y < 0.f ? m.y : r.y; return o;
}

template <int ACT  > struct EpiBf16 {
    static constexpr bool PERM = true, AFTER_DRAIN = false; static_assert(ACT == 0 || ACT == 1, "EpiBf16: ACT is 0 (none) or 1 (gelu_pk)");
    bf16_t* O; int ldc; const float* bias; int split_cols; size_t split_stride; float scale0;
    __device__ __forceinline__ void operator()(const f32x4 (&acc)[2][2][4][2], const Unit& u, int wr, int wc, int fr, int fq) const {
        const int row0 = u.pm * BM + wr * 64 + fr; int colt = u.pn * BM; bf16_t* base = O;
        float sc = 1.f; if (split_cols) { const int t = colt / split_cols; base += (size_t)t * split_stride; colt -= t * split_cols; if (t == 0) sc = scale0; }
        const int col0 = colt + wc * 32 + 8 * fq, bcol0 = u.pn * BM + wc * 32 + 8 * fq;
        f32x4 bv[2][2];
#pragma unroll
        for (int bj = 0; bj < 2; ++bj)
#pragma unroll
            for (int n = 0; n < 2; ++n) bv[bj][n] = bias ? *(const f32x4*)(bias + bcol0 + bj * HALF + 4 * n) : (f32x4){0.f, 0.f, 0.f, 0.f};
#pragma unroll
        for (int ai = 0; ai < 2; ++ai)
#pragma unroll
            for (int m = 0; m < 4; ++m) { bf16_t* rowp = base + (size_t)(row0 + ai * HALF + m * 16) * ldc + col0;
#pragma unroll
                for (int bj = 0; bj < 2; ++bj) { f32x4 v0 = acc[ai][bj][m][0] + bv[bj][0], v1 = acc[ai][bj][m][1] + bv[bj][1];
                    if (ACT == 1) { f32x2 a = gelu_pk((f32x2){v0[0], v0[1]}), b = gelu_pk((f32x2){v0[2], v0[3]}), c = gelu_pk((f32x2){v1[0], v1[1]}), d = gelu_pk((f32x2){v1[2], v1[3]});
                        v0 = (f32x4){a.x, a.y, b.x, b.y}; v1 = (f32x4){c.x, c.y, d.x, d.y}; }
                    v0 = v0 * sc; v1 = v1 * sc; u32x4 w; w.x = cvt_pk_bf16(v0[0], v0[1]); w.y = cvt_pk_bf16(v0[2], v0[3]); w.z = cvt_pk_bf16(v1[0], v1[1]); w.w = cvt_pk_bf16(v1[2], v1[3]);
                    *(u32x4*)(rowp + bj * HALF) = w; } }
    }
};
template <class Epi, class Sched, bool ALIGN_EPI = false, bool SP2 = false>
__device__ __forceinline__ void gemm_phase(PG8_LAS unsigned char* lds, const Gemm g, const Sched& S, const Epi& E) {
    const int tid = threadIdx.x, wid = __builtin_amdgcn_readfirstlane(tid >> 6), lane = tid & 63, wr = wid >> 2, wc = wid & 3, fr = lane & 15, fq = lane >> 4;
    const int K = g.K, nt = K / BK;
    unsigned voffA[2], voffB[2];
#pragma unroll
    for (int i = 0; i < 2; ++i) { int R, C; stage_rc(tid * 16 + i * 8192, R, C); const int Rb = Epi::PERM ? ((R & ~31) + perm32(R & 31)) : R;
        voffA[i] = (unsigned)(R * K + C) * 2u; voffB[i] = (unsigned)(Rb * K + C) * 2u; }
    const size_t kstep = (size_t)(BK * 2);
    const size_t hstep = (size_t)HALF * K * 2;
    const size_t tstep = 2 * hstep;
    const unsigned ldsw = (unsigned)wid * 1024u;
    const int aoff = lds_byte(wr * 64 + fr, fq * 8), boff = lds_byte(wc * 32 + fr, fq * 8);
#define PG8_SA(b, h) (((b) * 2 + (h)) * HTB)
#define PG8_SB(b, h) ((4 + (b) * 2 + (h)) * HTB)
#define PG8_STAGE(bufoff, gbase, voff) do { _Pragma("unroll") for (int _i = 0; _i < 2; ++_i) \
        __builtin_amdgcn_global_load_lds((const unsigned*)((const char*)(gbase) + (voff)[_i]), (PG8_LAS unsigned*)(lds + (bufoff) + ldsw + _i * 8192), 16, 0, 0); } while (0)
#define PG8_LDA(dst, b, h) do { _Pragma("unroll") for (int m = 0; m < 4; ++m) _Pragma("unroll") for (int k = 0; k < 2; ++k) dst[m][k] = *(const PG8_LAS bf16x8*)(lds + PG8_SA(b, h) + aoff + m * 2048 + k * 1024); } while (0)
#define PG8_LDB(dst, b, h) do { _Pragma("unroll") for (int n = 0; n < 2; ++n) _Pragma("unroll") for (int k = 0; k < 2; ++k) dst[n][k] = *(const PG8_LAS bf16x8*)(lds + PG8_SB(b, h) + boff + n * 2048 + k * 1024); } while (0)
#define PG8_MMA(ai, bj, At, Bt) do { __builtin_amdgcn_s_setprio(1); _Pragma("unroll") for (int m = 0; m < 4; ++m) _Pragma("unroll") for (int n = 0; n < 2; ++n) _Pragma("unroll") for (int k = 0; k < 2; ++k) \
        acc[ai][bj][m][n] = __builtin_amdgcn_mfma_f32_16x16x32_bf16(Bt[n][k], At[m][k], acc[ai][bj][m][n], 0, 0, 0); __builtin_amdgcn_s_setprio(0); } while (0)
#define PG8_WAIT_V(n) asm volatile("s_waitcnt vmcnt(" #n ")" ::: "memory")
#define PG8_WAIT_L(n) asm volatile("s_waitcnt lgkmcnt(" #n ")" ::: "memory")
#define PG8_BAR __builtin_amdgcn_s_barrier()
#define PG8_SCHED __builtin_amdgcn_sched_barrier(0)
    Unit cur, nxt; int ui = 0;
    if (!S.next(0, cur)) return;
    f32x4 acc[2][2][4][2];
#pragma unroll
    for (int a = 0; a < 2; ++a)
#pragma unroll
        for (int b = 0; b < 2; ++b)
#pragma unroll
            for (int m = 0; m < 4; ++m)
#pragma unroll
                for (int n = 0; n < 2; ++n) acc[a][b][m][n] = (f32x4){0.f, 0.f, 0.f, 0.f};
    bf16x8 At[4][2], B0[2][2], B1[2][2];
    const char* cA = (const char*)g.A + (size_t)cur.pm * tstep; const char* cB = (const char*)g.Bt + (size_t)cur.pn * tstep;
    S.a_ready(cur);
    if constexpr (SP2) {
        PG8_STAGE(PG8_SB(0, 0), cB, voffB); PG8_STAGE(PG8_SB(0, 1), cB + hstep, voffB); PG8_STAGE(PG8_SA(0, 0), cA, voffA); PG8_STAGE(PG8_SA(0, 1), cA + hstep, voffA);
        if (wr == 1) PG8_BAR;
        PG8_WAIT_V(2); PG8_BAR;
        PG8_STAGE(PG8_SB(1, 0), cB + kstep, voffB); PG8_STAGE(PG8_SA(1, 0), cA + kstep, voffA); PG8_STAGE(PG8_SB(1, 1), cB + hstep + kstep, voffB);
        PG8_WAIT_V(6); PG8_BAR;
    } else {
        PG8_STAGE(PG8_SB(0, 0), cB, voffB); PG8_STAGE(PG8_SA(0, 0), cA, voffA); PG8_STAGE(PG8_SB(0, 1), cB + hstep, voffB); PG8_STAGE(PG8_SA(0, 1), cA + hstep, voffA);
        if (wr == 1) PG8_BAR;
        PG8_WAIT_V(4); PG8_BAR;
        PG8_STAGE(PG8_SB(1, 0), cB + kstep, voffB); PG8_STAGE(PG8_SA(1, 0), cA + kstep, voffA); PG8_STAGE(PG8_SB(1, 1), cB + hstep + kstep, voffB);
        PG8_WAIT_V(6); PG8_BAR;
    }
    for (;;) {
        const bool has_next = S.next(ui + 1, nxt);
        const char* nA = has_next ? (const char*)g.A + (size_t)nxt.pm * tstep : cA; const char* nB = has_next ? (const char*)g.Bt + (size_t)nxt.pn * tstep : cB;
        for (int t = 0; t < nt; t += 2) {
            const bool last = (t == nt - 2);
            const char* a1 = cA + (size_t)(t + 1) * kstep;
            const char* a2 = last ? nA : cA + (size_t)(t + 2) * kstep; const char* b2 = last ? nB : cB + (size_t)(t + 2) * kstep;
            const char* a3 = a2 + kstep; const char* b3 = b2 + kstep;
            if (last && has_next) S.a_ready(nxt);
            if constexpr (SP2) {
            PG8_LDB(B0, 0, 0); PG8_LDB(B1, 0, 1); PG8_SCHED; PG8_LDA(At, 0, 0); PG8_STAGE(PG8_SA(1, 1), a1 + hstep, voffA);
            PG8_WAIT_V(8); PG8_WAIT_L(0); PG8_BAR; PG8_MMA(0, 0, At, B0); PG8_MMA(0, 1, At, B1); PG8_BAR; PG8_SCHED;
            PG8_LDA(At, 0, 1); PG8_STAGE(PG8_SB(0, 0), b2, voffB); PG8_STAGE(PG8_SB(0, 1), b2 + hstep, voffB); PG8_STAGE(PG8_SA(0, 0), a2, voffA);
            PG8_WAIT_V(8); PG8_WAIT_L(0); PG8_BAR; PG8_MMA(1, 0, At, B0); PG8_MMA(1, 1, At, B1); PG8_BAR; PG8_SCHED;
            PG8_LDB(B0, 1, 0); PG8_LDB(B1, 1, 1); PG8_SCHED; PG8_LDA(At, 1, 0); PG8_STAGE(PG8_SA(0, 1), a2 + hstep, voffA);
            PG8_WAIT_V(8); PG8_WAIT_L(0); PG8_BAR; PG8_MMA(0, 0, At, B0); PG8_MMA(0, 1, At, B1); PG8_BAR; PG8_SCHED;
            PG8_LDA(At, 1, 1); PG8_STAGE(PG8_SB(1, 0), b3, voffB); PG8_STAGE(PG8_SB(1, 1), b3 + hstep, voffB); PG8_STAGE(PG8_SA(1, 0), a3, voffA);
            PG8_WAIT_V(8); PG8_WAIT_L(0); PG8_BAR; PG8_MMA(1, 0, At, B0); PG8_MMA(1, 1, At, B1); PG8_BAR; PG8_SCHED;
            } else {
            PG8_LDB(B0, 0, 0); PG8_SCHED; PG8_LDA(At, 0, 0); PG8_STAGE(PG8_SA(1, 1), a1 + hstep, voffA);
            PG8_WAIT_L(8); PG8_BAR; PG8_WAIT_L(0); PG8_MMA(0, 0, At, B0); PG8_BAR; PG8_SCHED;
            PG8_LDB(B1, 0, 1); PG8_STAGE(PG8_SB(0, 0), b2, voffB);
            PG8_BAR; PG8_WAIT_L(0); PG8_MMA(0, 1, At, B1); PG8_BAR;
            PG8_LDA(At, 0, 1); PG8_STAGE(PG8_SA(0, 0), a2, voffA);
            PG8_BAR; PG8_WAIT_L(0); PG8_MMA(1, 0, At, B0); PG8_BAR; PG8_SCHED;
            PG8_STAGE(PG8_SB(0, 1), b2 + hstep, voffB);
            PG8_WAIT_V(6); PG8_BAR; PG8_MMA(1, 1, At, B1); PG8_BAR;
            PG8_LDB(B0, 1, 0); PG8_SCHED; PG8_LDA(At, 1, 0); PG8_STAGE(PG8_SA(0, 1), a2 + hstep, voffA);
            PG8_WAIT_L(8); PG8_BAR; PG8_WAIT_L(0); PG8_MMA(0, 0, At, B0); PG8_BAR; PG8_SCHED;
            PG8_LDB(B1, 1, 1); PG8_STAGE(PG8_SB(1, 0), b3, voffB);
            PG8_BAR; PG8_WAIT_L(0); PG8_MMA(0, 1, At, B1); PG8_BAR;
            PG8_LDA(At, 1, 1); PG8_STAGE(PG8_SA(1, 0), a3, voffA);
            PG8_BAR; PG8_WAIT_L(0); PG8_MMA(1, 0, At, B0); PG8_BAR; PG8_SCHED;
            PG8_STAGE(PG8_SB(1, 1), b3 + hstep, voffB);
            PG8_WAIT_V(6); PG8_BAR; PG8_MMA(1, 1, At, B1); PG8_BAR;
            }
        }
        if constexpr (ALIGN_EPI) { if (wr == 0) PG8_BAR; }
        if constexpr (!Epi::AFTER_DRAIN) { E(acc, cur, wr, wc, fr, fq); S.done(cur); }
        if (!has_next) break;
#pragma unroll
        for (int a = 0; a < 2; ++a)
#pragma unroll
            for (int b = 0; b < 2; ++b)
#pragma unroll
                for (int m = 0; m < 4; ++m)
#pragma unroll
                    for (int n = 0; n < 2; ++n) acc[a][b][m][n] = (f32x4){0.f, 0.f, 0.f, 0.f};
        cur = nxt; cA = nA; cB = nB; ++ui;
        if constexpr (ALIGN_EPI) { if (wr == 1) PG8_BAR; }
    }
    PG8_WAIT_V(0);
    if constexpr (!ALIGN_EPI) { if (wr == 0) PG8_BAR; }
    PG8_BAR;
    if constexpr (Epi::AFTER_DRAIN) { E.fused(acc, cur, wr, wc, fr, fq, lds, wid, lane); S.done(cur); }
#undef PG8_SA
#undef PG8_SB
#undef PG8_STAGE
#undef PG8_LDA
#undef PG8_LDB
#undef PG8_MMA
#undef PG8_WAIT_V
#undef PG8_WAIT_L
#undef PG8_BAR
#undef PG8_SCHED
}
}

namespace pg8 {
struct EpiSwiglu {
    static constexpr bool PERM = true, AFTER_DRAIN = false;
    bf16_t* O; int ldc; const float* rs;
    __device__ __forceinline__ void operator()(const f32x4 (&acc)[2][2][4][2], const Unit& u, int wr, int wc, int fr, int fq) const {
        const int row0 = u.pm * BM + wr * 64 + fr; const int col0 = u.pn * HALF + wc * 32 + 8 * fq;
#pragma unroll
        for (int ai = 0; ai < 2; ++ai)
#pragma unroll
            for (int m = 0; m < 4; ++m) { const int r = row0 + ai * HALF + m * 16; bf16_t* rowp = O + (size_t)r * ldc + col0; const float sc = rs[r];
                float v[8];
#pragma unroll
                for (int n = 0; n < 2; ++n)
#pragma unroll
                    for (int i = 0; i < 4; ++i) { const float g = acc[ai][0][m][n][i] * sc, up = acc[ai][1][m][n][i] * sc;
                        v[n * 4 + i] = g * __builtin_amdgcn_rcpf(1.0f + __expf(-g)) * up; }
                u32x4 w; w.x = cvt_pk_bf16(v[0], v[1]); w.y = cvt_pk_bf16(v[2], v[3]); w.z = cvt_pk_bf16(v[4], v[5]); w.w = cvt_pk_bf16(v[6], v[7]);
                *(u32x4*)rowp = w; }
    }
};
struct EpiBf16S {
    static constexpr bool PERM = true, AFTER_DRAIN = false;
    bf16_t* O; int ldc; const float* rs; const float* cs;
    __device__ __forceinline__ void operator()(const f32x4 (&acc)[2][2][4][2], const Unit& u, int wr, int wc, int fr, int fq) const {
        const int row0 = u.pm * BM + wr * 64 + fr; const int col0 = u.pn * BM + wc * 32 + 8 * fq;
        f32x4 cv[2][2];
#pragma unroll
        for (int bj = 0; bj < 2; ++bj)
#pragma unroll
            for (int n = 0; n < 2; ++n) cv[bj][n] = cs ? *(const f32x4*)(cs + col0 + bj * HALF + 4 * n) : (f32x4){1.f, 1.f, 1.f, 1.f};
#pragma unroll
        for (int ai = 0; ai < 2; ++ai)
#pragma unroll
            for (int m = 0; m < 4; ++m) { const int r = row0 + ai * HALF + m * 16; bf16_t* rowp = O + (size_t)r * ldc + col0; const float sc = rs ? rs[r] : 1.f;
#pragma unroll
                for (int bj = 0; bj < 2; ++bj) { const f32x4 v0 = acc[ai][bj][m][0] * sc * cv[bj][0], v1 = acc[ai][bj][m][1] * sc * cv[bj][1];
                    u32x4 w; w.x = cvt_pk_bf16(v0[0], v0[1]); w.y = cvt_pk_bf16(v0[2], v0[3]); w.z = cvt_pk_bf16(v1[0], v1[1]); w.w = cvt_pk_bf16(v1[2], v1[3]);
                    *(u32x4*)(rowp + bj * HALF) = w; } }
    }
};
}

constexpr int NWAVES = 8;
constexpr int BATCH = 8, SEQ = 2048, D = 2048, M = BATCH * SEQ;
constexpr int DFF = 5632;
constexpr int GLA_H = 4, GLA_HK = 256, GLA_HV = 512, GLA_IN = 6160;
constexpr int DH = 8;
constexpr float EPS = 1e-6f;
constexpr float LAMBDA_INIT = 0.35550906758f;
constexpr float LOG2E = 1.4426950408889634f;

constexpr size_t MiB = 1u << 20;
constexpr size_t WS_WG = 1 * MiB;
constexpr size_t WS_WINA = 2 * MiB;
constexpr size_t WS_WINV = 18 * MiB;
constexpr size_t WS_WOUTA = 26 * MiB;
constexpr size_t WS_WGU0 = 34 * MiB, WS_WGU1 = 78 * MiB;
constexpr size_t WS_WDN0 = 122 * MiB, WS_WDN1 = 144 * MiB;
constexpr size_t WS_WKQ = 166 * MiB;
constexpr size_t WS_WV = 182 * MiB;
constexpr size_t WS_WOUTB = 190 * MiB;
constexpr size_t WS_BUFA = 198 * MiB;
constexpr size_t WS_BUFB = 262 * MiB;
constexpr size_t WS_GLR = 326 * MiB;
constexpr size_t WS_DEC = 327 * MiB;
constexpr size_t WS_RS = 1 * MiB + 131072;
constexpr size_t WS_ATT = 328 * MiB;
constexpr size_t WS_R1 = 336 * MiB;
constexpr size_t WS_VT = WS_R1 + 128 * MiB, WS_QD = WS_R1 + 192 * MiB, WS_KET = WS_R1 + 224 * MiB;
constexpr size_t WS_XN0 = WS_R1 + 256 * MiB;
constexpr size_t WS_END = WS_XN0 + 64 * MiB;
constexpr size_t WS_SQ0 = WS_RS + 65536;
constexpr int LDS_BYTES = 147456;
constexpr int MISC_OFF = LDS_BYTES - 64;
constexpr size_t WS_CTL = 0;

#define GAS __attribute__((address_space(1)))
#define LAS __attribute__((address_space(3)))
typedef unsigned short bf16;
typedef unsigned v4u __attribute__((ext_vector_type(4)));
typedef unsigned v2u __attribute__((ext_vector_type(2)));
typedef float f32x4 __attribute__((ext_vector_type(4)));
typedef float f32x16 __attribute__((ext_vector_type(16)));
typedef short bf16x8 __attribute__((ext_vector_type(8)));
typedef float f32x2_t __attribute__((ext_vector_type(2)));
typedef __bf16 bf16x2_t __attribute__((ext_vector_type(2)));
typedef LAS unsigned char* ldsp;

__device__ __forceinline__ unsigned cvtpk(float lo, float hi) { f32x2_t v = {lo, hi}; bf16x2_t b = __builtin_convertvector(v, bf16x2_t); return __builtin_bit_cast(unsigned, b); }
__device__ __forceinline__ float bflo(unsigned w) { return __uint_as_float(w << 16); }
__device__ __forceinline__ float bfhi(unsigned w) { return __uint_as_float(w & 0xffff0000u); }
__device__ __forceinline__ float bf1(bf16 b) { return __uint_as_float((unsigned)b << 16); }
__device__ __forceinline__ float wave_sum(float v) {
#pragma unroll
    for (int o = 1; o < 64; o <<= 1) v += __shfl_xor(v, o);
    return v;
}
__device__ __forceinline__ int pi32(int i) { return (i & ~12) | ((i & 4) << 1) | ((i & 8) >> 1); }
__device__ __forceinline__ bf16x8 ld8(ldsp p) { return *(const LAS bf16x8*)p; }
__device__ __forceinline__ void st16(ldsp p, v4u v) { *(LAS v4u*)p = v; }
#define MFMA32(a, b, c) __builtin_amdgcn_mfma_f32_32x32x16_bf16((a), (b), (c), 0, 0, 0)
#define MFMA16(a, b, c) __builtin_amdgcn_mfma_f32_16x16x32_bf16((a), (b), (c), 0, 0, 0)

struct P0Desc { const float* src; const float* gain; bf16* dst; int ldw, K, mode, n0; };
__device__ __forceinline__ void p0_load(const P0Desc& d, f32x4 (&R)[16], int lane) {
    const float* p = d.src + (size_t)(lane >> 4) * d.ldw + (lane & 15) * 4;
#pragma unroll
    for (int i = 0; i < 16; ++i) R[i] = __builtin_nontemporal_load((const f32x4*)(p + (size_t)(4 * i) * d.ldw));
}
__device__ __forceinline__ void p0_to_lds(const f32x4 (&R)[16], LAS float* scr, int lane) {
#pragma unroll
    for (int i = 0; i < 16; ++i) *(LAS f32x4*)(scr + (4 * i + (lane >> 4)) * 68 + (lane & 15) * 4) = R[i];
}
__device__ __forceinline__ void p0_emit(const P0Desc& d, const LAS float* scr, int lane) {
    const int c = lane & 7;
    f32x4 g0 = {1.f, 1.f, 1.f, 1.f}, g1 = g0;
    if (d.gain) { g0 = *(const f32x4*)(d.gain + 8 * c); g1 = *(const f32x4*)(d.gain + 8 * c + 4); }
#pragma unroll
    for (int j = 0; j < 8; ++j) { const int n = (lane >> 3) + 8 * j; const LAS float* s = scr + (8 * c) * 68 + n;
        v4u o; o.x = cvtpk(s[0 * 68] * g0[0], s[1 * 68] * g0[1]); o.y = cvtpk(s[2 * 68] * g0[2], s[3 * 68] * g0[3]); o.z = cvtpk(s[4 * 68] * g1[0], s[5 * 68] * g1[1]); o.w = cvtpk(s[6 * 68] * g1[2], s[7 * 68] * g1[3]);
        const int cn = d.n0 + n; int drow;
        if (d.mode == 0) drow = cn; else { const int f = cn < DFF ? cn : cn - DFF; drow = 256 * (f >> 7) + (f & 127) + (cn < DFF ? 0 : 128); }
        *(v4u*)(d.dst + (size_t)drow * d.K + 8 * c) = o; }
}

__device__ __forceinline__ void rms_row(const float* xrow, bf16* orow, int lane) {
    const f32x4* xr = (const f32x4*)xrow + lane;
    f32x4 v[8]; float s = 0.f;
#pragma unroll
    for (int j = 0; j < 8; ++j) { v[j] = xr[64 * j]; s += (v[j].x * v[j].x + v[j].y * v[j].y) + (v[j].z * v[j].z + v[j].w * v[j].w); }
    const float rstd = 1.0f / sqrtf(wave_sum(s) * (1.f / D) + EPS);
    v2u* o8 = (v2u*)orow + lane;
#pragma unroll
    for (int j = 0; j < 8; ++j) { v2u w; w.x = cvtpk(v[j].x * rstd, v[j].y * rstd); w.y = cvtpk(v[j].z * rstd, v[j].w * rstd); o8[64 * j] = w; }
}

template <bool BASE_F32, bool OUT_F32>
__device__ __forceinline__ void norm_res_phase(const void* base, const bf16* src, const float* g, void* out, float* rs, const float* bsc, int gw, int NGW, int lane) {
    for (int m0 = 2 * gw; m0 < M; m0 += 2 * NGW) {
        f32x4 bv[2][8]; v2u sv[2][8];
#pragma unroll
        for (int r = 0; r < 2; ++r) { const v2u* sr = (const v2u*)(src + (size_t)(m0 + r) * D) + lane;
#pragma unroll
            for (int j = 0; j < 8; ++j) sv[r][j] = __builtin_nontemporal_load(sr + 64 * j); }
#pragma unroll
        for (int r = 0; r < 2; ++r) {
            if (BASE_F32) { const f32x4* br = (const f32x4*)((const float*)base + (size_t)(m0 + r) * D) + lane;
#pragma unroll
                for (int j = 0; j < 8; ++j) bv[r][j] = __builtin_nontemporal_load(br + 64 * j); }
            else { const v2u* br = (const v2u*)((const bf16*)base + (size_t)(m0 + r) * D) + lane;
#pragma unroll
                for (int j = 0; j < 8; ++j) { const v2u w = br[64 * j]; bv[r][j] = (f32x4){bflo(w.x), bfhi(w.x), bflo(w.y), bfhi(w.y)}; }
                if (bsc) { const float sc = bsc[m0 + r];
#pragma unroll
                    for (int j = 0; j < 8; ++j) bv[r][j] = bv[r][j] * sc; } }
        }
#pragma unroll
        for (int r = 0; r < 2; ++r) {
            f32x4 v[8]; float ss = 0.f;
#pragma unroll
            for (int j = 0; j < 8; ++j) { const v2u w = sv[r][j]; v[j] = (f32x4){bflo(w.x), bfhi(w.x), bflo(w.y), bfhi(w.y)}; ss += (v[j].x * v[j].x + v[j].y * v[j].y) + (v[j].z * v[j].z + v[j].w * v[j].w); }
            const float rstd = 1.0f / sqrtf(wave_sum(ss) * (1.f / D) + EPS);
            float s2 = 0.f;
#pragma unroll
            for (int j = 0; j < 8; ++j) { const f32x4 gv = ((const f32x4*)g)[lane + 64 * j]; v[j] = bv[r][j] + v[j] * rstd * gv;
                s2 += (v[j].x * v[j].x + v[j].y * v[j].y) + (v[j].z * v[j].z + v[j].w * v[j].w); }
            if (OUT_F32) { f32x4* orow = (f32x4*)((float*)out + (size_t)(m0 + r) * D) + lane;
#pragma unroll
                for (int j = 0; j < 8; ++j) __builtin_nontemporal_store(v[j], orow + 64 * j); }
            else { v2u* orow = (v2u*)((bf16*)out + (size_t)(m0 + r) * D) + lane;
#pragma unroll
                for (int j = 0; j < 8; ++j) { v2u w; w.x = cvtpk(v[j].x, v[j].y); w.y = cvtpk(v[j].z, v[j].w); orow[64 * j] = w; } }
            if (rs) { const float r2 = 1.0f / sqrtf(wave_sum(s2) * (1.f / D) + EPS); if (lane == 0) rs[m0 + r] = r2; }
        }
    }
}

__device__ __forceinline__ void glr_phase(ldsp lds, const bf16* XN, const bf16* WG, float* GLR, int G, int tid) {
    asm volatile("" : "+v"(tid));
    const int lane = tid & 63, w = __builtin_amdgcn_readfirstlane(tid >> 6), rb = w & 3, kh = w >> 2, i = lane & 15, q = lane >> 4;
    LAS float* red = (LAS float*)lds;
    for (int blk = blockIdx.x; blk < M / 64; blk += G) {
        const bf16* ap = XN + (size_t)(blk * 64 + rb * 16 + i) * D + kh * 1024 + 8 * q;
        const bf16* bp = WG + (size_t)i * D + kh * 1024 + 8 * q;
        f32x4 acc = {0.f, 0.f, 0.f, 0.f};
#pragma unroll 8
        for (int s = 0; s < 32; ++s) { const bf16x8 a = *(const bf16x8*)(ap + 32 * s); const bf16x8 b = *(const bf16x8*)(bp + 32 * s); acc = MFMA16(a, b, acc); }
        if (kh == 1) *(LAS f32x4*)(red + (rb * 64 + lane) * 4) = acc;
        __syncthreads();
        if (kh == 0) { const f32x4 o = *(LAS f32x4*)(red + (rb * 64 + lane) * 4); acc = acc + o;
#pragma unroll
            for (int r = 0; r < 4; ++r) GLR[(size_t)(blk * 64 + rb * 16 + 4 * q + r) * 16 + i] = acc[r]; }
        __syncthreads();
    }
}

__device__ __forceinline__ void gla_pre_phase(ldsp lds, const bf16* PROJ, const float* GLR, const float* wfg, const float* bfg, bf16* QDg, bf16* KETg, bf16* ATTg, float* DECg, int vcu, int G, int tid) {
    asm volatile("" : "+v"(tid));
    const int lane = tid & 63, w = __builtin_amdgcn_readfirstlane(tid >> 6), r32 = lane & 31, hi = lane >> 5;
    const int d = tid & 255, half = tid >> 8;
    const ldsp QD = lds, KI = lds + 33792;
    LAS float* GL = (LAS float*)(lds + 67584); LAS float* TOT = (LAS float*)(lds + 71680); LAS float* RED = (LAS float*)(lds + 73728);
    v4u pq[4], pk[4]; f32x4 pg = {0.f, 0.f, 0.f, 0.f};
#define G1_PREFETCH(it_) do { const int b_ = (it_) >> 7, h_ = ((it_) >> 5) & 3, n_ = (it_) & 31; const int t0_ = b_ * SEQ + n_ * 64; \
        _Pragma("unroll") for (int cc = 0; cc < 4; ++cc) { const int idx = tid + 512 * cc; const bf16* gp = PROJ + (size_t)(t0_ + (idx >> 5)) * 4096 + h_ * 256 + (idx & 31) * 8; pq[cc] = *(const v4u*)gp; pk[cc] = *(const v4u*)(gp + 1024); } \
        if (tid < 256) pg = *(const f32x4*)(GLR + (size_t)t0_ * 16 + tid * 4); } while (0)
    if (vcu < 1024) G1_PREFETCH(vcu);
    float wf[16], bias = 0.f; int hprev = -1;
#pragma unroll
    for (int r = 0; r < 16; ++r) wf[r] = 0.f;
    for (int item = vcu; item < 1024; item += G) {
        const int b = item >> 7, h = (item >> 5) & 3, n = item & 31; const int tok0 = b * SEQ + n * 64;
#pragma unroll
        for (int cc = 0; cc < 4; ++cc) { const int idx = tid + 512 * cc, row = idx >> 5, ch = idx & 31; st16(QD + (row * 264 + ch * 8) * 2, pq[cc]); st16(KI + (row * 264 + ch * 8) * 2, pk[cc]); }
        if (tid < 256) *(LAS f32x4*)(GL + tid * 4) = pg;
        { const int nit = item + G; if (nit < 1024) G1_PREFETCH(nit); }
        if (h != hprev) { hprev = h;
#pragma unroll
            for (int r = 0; r < 16; ++r) wf[r] = wfg[r * 1024 + h * 256 + d] * LOG2E;
            bias = bfg[h * 256 + d] * LOG2E; }
        __syncthreads();
        float bc[32]; float c = 0.f;
#pragma unroll
        for (int t = 0; t < 32; ++t) { const LAS float* gr = GL + (half * 32 + t) * 16; float z = bias;
#pragma unroll
            for (int r = 0; r < 16; ++r) z += gr[r] * wf[r];
            const float ls = fmaxf(-z, 0.f) + __builtin_amdgcn_logf(1.0f + __builtin_amdgcn_exp2f(-fabsf(z)));
            c -= ls * (1.0f / 16.0f); bc[t] = c; }
        TOT[half * 256 + d] = c;
        __syncthreads();
        const float tot0 = TOT[d], tot1 = TOT[256 + d]; const float blast = tot0 + tot1; const float add = half ? tot0 : 0.f;
        unsigned ke[16];
#pragma unroll
        for (int t = 0; t < 32; ++t) { const float bcv = bc[t] + add; const int row = half * 32 + t;
            const float qv = bf1(*(const LAS bf16*)(QD + (row * 264 + d) * 2)), kv = bf1(*(const LAS bf16*)(KI + (row * 264 + d) * 2));
            const float qd = qv * 0.0625f * __builtin_amdgcn_exp2f(bcv); const float ki = kv * __builtin_amdgcn_exp2f(-bcv); const float kev = kv * __builtin_amdgcn_exp2f(blast - bcv);
            *(LAS bf16*)(QD + (row * 264 + d) * 2) = (bf16)(cvtpk(qd, 0.f) & 0xffffu);
            *(LAS bf16*)(KI + (row * 264 + d) * 2) = (bf16)(cvtpk(ki, 0.f) & 0xffffu);
            if (t & 1) ke[t >> 1] |= cvtpk(0.f, kev) & 0xffff0000u; else ke[t >> 1] = cvtpk(kev, 0.f) & 0xffffu; }
        { v4u* kp = (v4u*)(KETg + (size_t)item * 16384 + d * 64 + half * 32);
#pragma unroll
          for (int j = 0; j < 4; ++j) kp[j] = (v4u){ke[4 * j], ke[4 * j + 1], ke[4 * j + 2], ke[4 * j + 3]}; }
        if (half == 0) DECg[item * 256 + d] = __builtin_amdgcn_exp2f(blast);
        __syncthreads();
#pragma unroll
        for (int cc = 0; cc < 4; ++cc) { const int idx = tid + 512 * cc, row = idx >> 5, ch = idx & 31; *(v4u*)(QDg + (size_t)item * 16384 + row * 256 + ch * 8) = *(const LAS v4u*)(QD + (row * 264 + ch * 8) * 2); }
        { const int tile = w & 3, ti = tile >> 1, si = tile & 1, kh = w >> 2;
          f32x16 acc = {};
          const ldsp ap = KI + ((32 * si + pi32(r32)) * 264 + kh * 128 + 8 * hi) * 2; const ldsp bp = QD + ((32 * ti + r32) * 264 + kh * 128 + 8 * hi) * 2;
#pragma unroll
          for (int s = 0; s < 8; ++s) acc = MFMA32(ld8(ap + s * 32), ld8(bp + s * 32), acc);
          if (kh == 1) {
#pragma unroll
              for (int r = 0; r < 16; ++r) RED[(tile * 16 + r) * 64 + lane] = acc[r]; }
          __syncthreads();
          if (kh == 0) { const int t = 32 * ti + r32; unsigned pk[8];
#pragma unroll
              for (int r = 0; r < 16; r += 2) { float v0 = acc[r] + RED[(tile * 16 + r) * 64 + lane], v1 = acc[r + 1] + RED[(tile * 16 + r + 1) * 64 + lane];
                  const int s0 = 32 * si + 16 * (r >> 3) + 8 * hi + (r & 7);
                  if (s0 > t) v0 = 0.f; if (s0 + 1 > t) v1 = 0.f; pk[r >> 1] = cvtpk(v0, v1); }
              bf16* op = ATTg + (size_t)item * 4096 + t * 64 + 32 * si + 8 * hi;
              *(v4u*)op = (v4u){pk[0], pk[1], pk[2], pk[3]}; *(v4u*)(op + 16) = (v4u){pk[4], pk[5], pk[6], pk[7]}; }
        }
        __syncthreads();
    }
}

#undef G1_PREFETCH
__device__ __forceinline__ void gla_scan_phase(ldsp lds, const bf16* QDg, const bf16* KETg, const bf16* ATTg, const float* DECg, const bf16* VTg, bf16* O1, int vcu, int G, int tid) {
    asm volatile("" : "+v"(tid));
    const int lane = tid & 63, w = __builtin_amdgcn_readfirstlane(tid >> 6), r32 = lane & 31, hi = lane >> 5, i16 = lane & 15, q4 = lane >> 4;
    const ldsp QD = lds, KET = lds + 33792, ATT = lds + 70656, VT = lds + 79872, ST = lds + 89088; LAS float* DEC = (LAS float*)(lds + 122880);
    for (int item = vcu; item < 256; item += G) {
        const int bh = item >> 3, b = bh >> 2, h = bh & 3, j = item & 7;
        f32x16 st[2]; st[0] = (f32x16){}; st[1] = (f32x16){};
        __syncthreads();
        for (int u = tid; u < 33792 / 16; u += 512) st16(ST + u * 16, (v4u){0u, 0u, 0u, 0u});
        v4u rq[4], rk[4], ra, rv; f32x4 rd = {0.f, 0.f, 0.f, 0.f};
#define G2_LOAD(nn) do { const size_t cb = (size_t)(bh * 32 + (nn)); const int tok0_ = b * SEQ + (nn) * 64; \
        _Pragma("unroll") for (int cc = 0; cc < 4; ++cc) { rq[cc] = *(const v4u*)(QDg + cb * 16384 + (size_t)(tid + 512 * cc) * 8); rk[cc] = *(const v4u*)(KETg + cb * 16384 + (size_t)(tid + 512 * cc) * 8); } \
        ra = *(const v4u*)(ATTg + cb * 4096 + tid * 8); rv = *(const v4u*)(VTg + (size_t)(h * 512 + j * 64 + (tid >> 3)) * M + tok0_ + (tid & 7) * 8); \
        if (tid < 64) rd = *(const f32x4*)(DECg + cb * 256 + tid * 4); } while (0)
#define G2_STORE() do { _Pragma("unroll") for (int cc = 0; cc < 4; ++cc) { const int idx = tid + 512 * cc; st16(QD + ((idx >> 5) * 264 + (idx & 31) * 8) * 2, rq[cc]); st16(KET + ((idx >> 3) * 72 + (idx & 7) * 8) * 2, rk[cc]); } \
        st16(ATT + ((tid >> 3) * 72 + (tid & 7) * 8) * 2, ra); st16(VT + ((tid >> 3) * 72 + (tid & 7) * 8) * 2, rv); if (tid < 64) *(LAS f32x4*)(DEC + tid * 4) = rd; } while (0)
        G2_LOAD(0);
        G2_STORE();
        for (int n = 0; n < 32; ++n) {
            if (n + 1 < 32) G2_LOAD(n + 1);
            __syncthreads();
            { const int tb = w & 3, ebp = w >> 2; f32x4 a0 = {0.f, 0.f, 0.f, 0.f}, a1 = {0.f, 0.f, 0.f, 0.f};
              const ldsp bA = ATT + ((16 * tb + i16) * 72 + 8 * q4) * 2, bQ = QD + ((16 * tb + i16) * 264 + 8 * q4) * 2;
              const ldsp v0 = VT + ((32 * ebp + i16) * 72 + 8 * q4) * 2, v1 = v0 + 16 * 72 * 2;
              const ldsp s0 = ST + ((32 * ebp + i16) * 264 + 8 * q4) * 2, s1 = s0 + 16 * 264 * 2;
              bf16x8 bb[10], aa[8];
#pragma unroll
              for (int ks = 0; ks < 2; ++ks) bb[ks] = ld8(bA + ks * 64);
#pragma unroll
              for (int ks = 0; ks < 8; ++ks) bb[2 + ks] = ld8(bQ + ks * 64);
              aa[0] = ld8(v0); aa[1] = ld8(v1); aa[2] = ld8(v0 + 64); aa[3] = ld8(v1 + 64); aa[4] = ld8(s0); aa[5] = ld8(s1); aa[6] = ld8(s0 + 64); aa[7] = ld8(s1 + 64);
              __builtin_amdgcn_sched_barrier(0);
#pragma unroll
              for (int i = 0; i < 4; ++i) { a0 = MFMA16(aa[2 * i], bb[i], a0); a1 = MFMA16(aa[2 * i + 1], bb[i], a1); }
              __builtin_amdgcn_sched_barrier(0);
#pragma unroll
              for (int i = 0; i < 4; ++i) { aa[2 * i] = ld8(s0 + (2 + i) * 64); aa[2 * i + 1] = ld8(s1 + (2 + i) * 64); }
              __builtin_amdgcn_sched_barrier(0);
#pragma unroll
              for (int i = 0; i < 4; ++i) { a0 = MFMA16(aa[2 * i], bb[4 + i], a0); a1 = MFMA16(aa[2 * i + 1], bb[4 + i], a1); }
              __builtin_amdgcn_sched_barrier(0);
#pragma unroll
              for (int i = 0; i < 2; ++i) { aa[2 * i] = ld8(s0 + (6 + i) * 64); aa[2 * i + 1] = ld8(s1 + (6 + i) * 64); }
              __builtin_amdgcn_sched_barrier(0);
#pragma unroll
              for (int i = 0; i < 2; ++i) { a0 = MFMA16(aa[2 * i], bb[8 + i], a0); a1 = MFMA16(aa[2 * i + 1], bb[8 + i], a1); }
              __builtin_amdgcn_sched_barrier(0);
              bf16* op = O1 + (size_t)(b * SEQ + n * 64 + 16 * tb + i16) * D + h * 512 + j * 64 + 32 * ebp + 4 * q4;
              *(v2u*)op = (v2u){cvtpk(a0[0], a0[1]), cvtpk(a0[2], a0[3])}; *(v2u*)(op + 16) = (v2u){cvtpk(a1[0], a1[1]), cvtpk(a1[2], a1[3])}; }
            { float dc[16];
#pragma unroll
              for (int g = 0; g < 2; ++g) { const f32x4 x0 = *(const LAS f32x4*)(DEC + 32 * w + 16 * g + 8 * hi), x1 = *(const LAS f32x4*)(DEC + 32 * w + 16 * g + 8 * hi + 4);
                  dc[8 * g + 0] = x0[0]; dc[8 * g + 1] = x0[1]; dc[8 * g + 2] = x0[2]; dc[8 * g + 3] = x0[3]; dc[8 * g + 4] = x1[0]; dc[8 * g + 5] = x1[1]; dc[8 * g + 6] = x1[2]; dc[8 * g + 7] = x1[3]; }
              const ldsp ka = KET + ((32 * w + pi32(r32)) * 72 + 8 * hi) * 2; const ldsp vb0 = VT + (r32 * 72 + 8 * hi) * 2, vb1 = vb0 + 32 * 72 * 2;
              bf16x8 ka4[4], va4[4], vb4[4];
#pragma unroll
              for (int ks = 0; ks < 4; ++ks) { ka4[ks] = ld8(ka + ks * 32); va4[ks] = ld8(vb0 + ks * 32); vb4[ks] = ld8(vb1 + ks * 32); }
#pragma unroll
              for (int r = 0; r < 16; ++r) { st[0][r] *= dc[r]; st[1][r] *= dc[r]; }
              __builtin_amdgcn_sched_barrier(0);
#pragma unroll
              for (int ks = 0; ks < 4; ++ks) { st[0] = MFMA32(ka4[ks], va4[ks], st[0]); st[1] = MFMA32(ka4[ks], vb4[ks], st[1]); }
              __builtin_amdgcn_sched_barrier(0); }
            __syncthreads();
#pragma unroll
            for (int eb = 0; eb < 2; ++eb)
#pragma unroll
                for (int g = 0; g < 2; ++g) st16(ST + ((32 * eb + r32) * 264 + 32 * w + 16 * g + 8 * hi) * 2,
                    (v4u){cvtpk(st[eb][8 * g], st[eb][8 * g + 1]), cvtpk(st[eb][8 * g + 2], st[eb][8 * g + 3]), cvtpk(st[eb][8 * g + 4], st[eb][8 * g + 5]), cvtpk(st[eb][8 * g + 6], st[eb][8 * g + 7])});
            if (n + 1 < 32) G2_STORE();
        }
#undef G2_LOAD
#undef G2_STORE
    }
}

__device__ __forceinline__ void gla_gate_phase(const bf16* O1, const bf16* PROJ, const float* gn, bf16* A2, int gw, int NGW, int lane) {
    const f32x4 g0 = *(const f32x4*)(gn + lane * 8), g1 = *(const f32x4*)(gn + lane * 8 + 4);
    const float g[8] = {g0[0], g0[1], g0[2], g0[3], g1[0], g1[1], g1[2], g1[3]};
    for (int tok = gw; tok < M; tok += NGW) {
        v4u ov[4], rv[4];
#pragma unroll
        for (int h = 0; h < 4; ++h) { ov[h] = __builtin_nontemporal_load((const v4u*)(O1 + (size_t)tok * D + h * 512 + lane * 8)); rv[h] = __builtin_nontemporal_load((const v4u*)(PROJ + (size_t)tok * 4096 + 2048 + h * 512 + lane * 8)); }
#pragma unroll
        for (int h = 0; h < 4; ++h) {
            float o[8] = {bflo(ov[h].x), bfhi(ov[h].x), bflo(ov[h].y), bfhi(ov[h].y), bflo(ov[h].z), bfhi(ov[h].z), bflo(ov[h].w), bfhi(ov[h].w)};
            float r[8] = {bflo(rv[h].x), bfhi(rv[h].x), bflo(rv[h].y), bfhi(rv[h].y), bflo(rv[h].z), bfhi(rv[h].z), bflo(rv[h].w), bfhi(rv[h].w)};
            float ss = 0.f;
#pragma unroll
            for (int i = 0; i < 8; ++i) ss += o[i] * o[i];
            const float rstd = 1.0f / sqrtf(wave_sum(ss) * (1.f / 512.f) + EPS);
            float y[8];
#pragma unroll
            for (int i = 0; i < 8; ++i) y[i] = o[i] * rstd * g[i] * (r[i] * __builtin_amdgcn_rcpf(1.0f + __expf(-r[i])));
            *(v4u*)(A2 + (size_t)tok * D + h * 512 + lane * 8) = (v4u){cvtpk(y[0], y[1]), cvtpk(y[2], y[3]), cvtpk(y[4], y[5]), cvtpk(y[6], y[7])}; }
    }
}
#define XB_TMO      128
#define XB_XCNT(j)  (256  + 64 * (j))
#define XB_XSUB(j)  (1280 + 64 * (j))
#define XB_XGEN(j)  (2304 + 64 * (j))
#define XB_TOP      3328
#define XB_TOPGEN   3392
#define XCD_BAR_WORDS 3456
#define XB_SPIN_CAP (1u << 18)

__device__ __forceinline__ unsigned xb_ld(unsigned* p)              { return __hip_atomic_load(p, __ATOMIC_RELAXED, __HIP_MEMORY_SCOPE_AGENT); }
__device__ __forceinline__ unsigned xb_add(unsigned* p, unsigned v) { return __hip_atomic_fetch_add(p, v, __ATOMIC_RELAXED, __HIP_MEMORY_SCOPE_AGENT); }
__device__ __forceinline__ unsigned xb_xcc_id() { return (unsigned)__builtin_amdgcn_s_getreg((3 << 11) | 20) & 0xFu; }
#define XB_SPIN(cond, bar) do { unsigned _sp = 0; while (cond) { __builtin_amdgcn_s_sleep(1); \
    if ((++_sp & 255u) == 0u) { if (xb_ld(&(bar)[XB_TMO])) break; if (_sp > XB_SPIN_CAP) { atomicAdd(&(bar)[XB_TMO], 1u); break; } } } } while (0)

struct XcdBarrier {
    unsigned* bar; unsigned x;
    volatile LAS unsigned* st;
};

__device__ __forceinline__ XcdBarrier xcd_barrier_post(unsigned* bar, volatile LAS unsigned* st) {
    XcdBarrier b; b.bar = bar; b.x = xb_xcc_id(); b.st = st;
    if (threadIdx.x == 0) (void)xb_add(&bar[XB_XCNT(b.x)], 1u);
    return b;
}
__device__ __forceinline__ void xcd_barrier_complete(unsigned* bar, unsigned x, unsigned& nloc, unsigned& nx) {
    const unsigned G = gridDim.x * gridDim.y * gridDim.z;
    unsigned sum, cnt, mine, sp = 0u;
    for (;;) {
        sum = 0u; cnt = 0u; mine = 0u;
#pragma unroll
        for (unsigned j = 0; j < 16; ++j) { const unsigned c = xb_ld(&bar[XB_XCNT(j)]); sum += c; cnt += (c > 0u) ? 1u : 0u; mine = (j == x) ? c : mine; }
        if (sum == G) break;
        __builtin_amdgcn_s_sleep(1);
        if ((++sp & 255u) == 0u) { if (xb_ld(&bar[XB_TMO])) break; if (sp > XB_SPIN_CAP) { atomicAdd(&bar[XB_TMO], 1u); break; } }
    }
    nloc = mine > 0u ? mine : 1u; nx = cnt > 0u ? cnt : 1u;
}

__device__ __forceinline__ void xcd_barrier(const XcdBarrier& b) {
    asm volatile("s_waitcnt vmcnt(0)" ::: "memory");
    __syncthreads();
    if (threadIdx.x == 0) {
        unsigned* bar = b.bar;
        __builtin_amdgcn_s_waitcnt(0);
        unsigned nloc = b.st[0], nx = b.st[1];
        if (nloc == 0u) { xcd_barrier_complete(bar, b.x, nloc, nx); b.st[0] = nloc; b.st[1] = nx; }
        const unsigned old = xb_add(&bar[XB_XSUB(b.x)], 1u);
        const unsigned gen = old / nloc;
        if (old + 1u == (gen + 1u) * nloc) {
            __builtin_amdgcn_fence(__ATOMIC_RELEASE, "agent");
            asm volatile("s_waitcnt vmcnt(0)" ::: "memory");
            const unsigned og = xb_add(&bar[XB_TOP], 1u);
            const unsigned tg = og / nx;
            if (og + 1u == (tg + 1u) * nx) xb_add(&bar[XB_TOPGEN], 1u);
            else XB_SPIN(xb_ld(&bar[XB_TOPGEN]) == tg, bar);
            __builtin_amdgcn_fence(__ATOMIC_ACQUIRE, "agent");
            xb_add(&bar[XB_XGEN(b.x)], 1u);
            asm volatile("s_waitcnt vmcnt(0)" ::: "memory");
        } else {
            XB_SPIN(xb_ld(&bar[XB_XGEN(b.x)]) == gen, bar);
            __builtin_amdgcn_fence(__ATOMIC_ACQUIRE, "agent");
            asm volatile("s_waitcnt vmcnt(0)" ::: "memory");
        }
    }
    __syncthreads();
}

__device__ __forceinline__ void attn_phase(ldsp lds, const bf16* KQ, const bf16* VTa, const float* relb, const float* lq1, const float* lk1, const float* lq2, const float* lk2,
                                           const float* subg, bf16* O2, int vcu, int G, int tid) {
    asm volatile("" : "+v"(tid));
    const int lane = tid & 63, w = __builtin_amdgcn_readfirstlane(tid >> 6), i16 = lane & 15, g4 = lane >> 4;
    const int mh = w >> 2, qb4 = w & 3;
    constexpr int ABUF = 65536;
    LAS float* TB = (LAS float*)(lds + 2 * ABUF); LAS float* LAMS = (LAS float*)(lds + 2 * ABUF + 1024); LAS float* XO = (LAS float*)lds;
    if (w == 0) { float a = lq1[lane] * lk1[lane] + lq1[lane + 64] * lk1[lane + 64], b = lq2[lane] * lk2[lane] + lq2[lane + 64] * lk2[lane + 64];
        a = wave_sum(a); b = wave_sum(b); if (lane == 0) LAMS[0] = expf(a) - expf(b) + LAMBDA_INIT; }
    const float c1 = 0.08838834764831845f * LOG2E;
    for (int v = vcu; v < 256; v += G) {
        const int h = v >> 5, cq = v & 31;
        __syncthreads();
        { int t2 = tid; asm volatile("" : "+v"(t2));
          if (t2 < 129) { int bucket; if (t2 < 16) bucket = t2; else { bucket = 16 + (int)(logf((float)t2 * (1.0f / 16.0f)) / 2.0794415416798357f * 16.0f); if (bucket > 31) bucket = 31; }
            TB[t2] = relb[bucket * 8 + h] * 11.313708498984761f; } }
        for (int ui = 0; ui < 8; ++ui) {
            const int b = ui; const int qb = (ui & 1) ? 31 - cq : cq;
            const int q0 = qb * 64; const int qrow = 16 * qb4 + i16; const size_t tokq = (size_t)b * SEQ + q0 + qrow;
            bf16x8 qf[4];
#pragma unroll
            for (int ks = 0; ks < 4; ++ks) qf[ks] = *(const bf16x8*)(KQ + tokq * 4096 + 2048 + h * 256 + mh * 128 + 32 * ks + 8 * g4);
            f32x4 o[16];
#pragma unroll
            for (int eb = 0; eb < 16; ++eb) o[eb] = (f32x4){0.f, 0.f, 0.f, 0.f};
            float mrun = -INFINITY, lrun = 0.f;
            unsigned kdo[4], vdo[4];
#pragma unroll
            for (int cc = 0; cc < 4; ++cc) { const int p = 4 * w + cc;
                const int lr = 2 * p + (lane >> 5), ch = (lane & 31) ^ (lr & 15), i_ = lr & 15, t_ = (lr >> 4) & 1, gr = (lr & ~31) + 8 * (i_ >> 2) + 4 * t_ + (i_ & 3);
                kdo[cc] = (unsigned)(gr * 4096 + ch * 8);
                const int le = 8 * p + (lane >> 3), cv = (lane & 7) ^ ((le >> 1) & 7), iv = le & 15, tv = (le >> 4) & 1, ge = (le & ~31) + 8 * (iv >> 2) + 4 * tv + (iv & 3);
                vdo[cc] = (unsigned)(ge * M + cv * 8); }
#define AT_DMA(kt_, bs_) do { const bf16* kb_ = KQ + ((size_t)b * SEQ + 64 * (kt_)) * 4096 + h * 256; const bf16* vb_ = VTa + (size_t)(h * 256) * M + (size_t)b * SEQ + 64 * (kt_); \
            _Pragma("unroll") for (int cc = 0; cc < 4; ++cc) { \
                __builtin_amdgcn_global_load_lds((const unsigned*)(kb_ + kdo[cc]), (LAS unsigned*)(lds + (bs_) * ABUF + (4 * w + cc) * 1024), 16, 0, 0); \
                __builtin_amdgcn_global_load_lds((const unsigned*)(vb_ + vdo[cc]), (LAS unsigned*)(lds + (bs_) * ABUF + 32768 + (4 * w + cc) * 1024), 16, 0, 0); } } while (0)
            __syncthreads();
            AT_DMA(0, 0);
            asm volatile("s_waitcnt vmcnt(0)" : "+v"(qf[0]), "+v"(qf[1]), "+v"(qf[2]), "+v"(qf[3]) :: "memory");
            for (int kt = 0; kt <= qb; ++kt) {
                asm volatile("s_waitcnt vmcnt(0)" ::: "memory"); __syncthreads();
                if (kt + 1 <= qb) AT_DMA(kt + 1, (kt + 1) & 1);
                const ldsp Kb = lds + (kt & 1) * ABUF + i16 * 512 + mh * 256, Vb = lds + (kt & 1) * ABUF + 32768 + i16 * 128;
                const int kx = g4 ^ i16, vx = g4 ^ (i16 >> 1);
                const ldsp kbs0 = Kb + kx * 16, kbs1 = Kb + (kx ^ 4) * 16, kbs2 = Kb + (kx ^ 8) * 16, kbs3 = Kb + (kx ^ 12) * 16, vbs0 = Vb + vx * 16, vbs1 = Vb + (vx ^ 4) * 16;
                const int k0 = 64 * kt;
#define SB() __builtin_amdgcn_sched_barrier(0)
#define LDK(dst, hf_, bt_) do { _Pragma("unroll") for (int j_ = 0; j_ < 2; ++j_) _Pragma("unroll") for (int t_ = 0; t_ < 2; ++t_) dst[2 * j_ + t_] = ld8(((2 * (bt_) + j_) == 0 ? kbs0 : (2 * (bt_) + j_) == 1 ? kbs1 : (2 * (bt_) + j_) == 2 ? kbs2 : kbs3) + (32 * (hf_) + 16 * t_) * 512); } while (0)
#define LDV(dst, hf_, bt_) do { _Pragma("unroll") for (int j_ = 0; j_ < 4; ++j_) dst[j_] = ld8(((hf_) == 0 ? vbs0 : vbs1) + (4 * (bt_) + j_) * 16 * 128); } while (0)
#define MMK(src, bt_) do { s[0] = MFMA16(src[0], qf[2 * (bt_)], s[0]); s[1] = MFMA16(src[1], qf[2 * (bt_)], s[1]); s[0] = MFMA16(src[2], qf[2 * (bt_) + 1], s[0]); s[1] = MFMA16(src[3], qf[2 * (bt_) + 1], s[1]); } while (0)
#define MMV(src, bt_) do { _Pragma("unroll") for (int j_ = 0; j_ < 4; ++j_) o[4 * (bt_) + j_] = MFMA16(src[j_], pb, o[4 * (bt_) + j_]); } while (0)
                bf16x8 X[4], Y[4];
                LDK(X, 0, 0); SB();
#pragma unroll
                for (int hf = 0; hf < 2; ++hf) {
                    f32x4 s[2];
                    const int dbase = q0 + qrow - k0 - 32 * hf - 8 * g4;
                    if (q0 - k0 - 32 * hf - 31 >= 128) { const float cb = TB[128]; s[0] = (f32x4){cb, cb, cb, cb}; s[1] = s[0]; }
                    else {
#pragma unroll
                        for (int t = 0; t < 2; ++t)
#pragma unroll
                            for (int r = 0; r < 4; ++r) { const int d0 = dbase - 4 * t - r; const float b0 = TB[min(max(d0, 0), 128)]; s[t][r] = d0 < 0 ? -INFINITY : b0; }
                    }
                    SB(); LDK(Y, hf, 1); SB();
                    MMK(X, 0); SB();
                    LDV(X, hf, 0); SB();
                    MMK(Y, 1); SB();
                    float mx = fmaxf(fmaxf(fmaxf(s[0][0], s[0][1]), fmaxf(s[0][2], s[0][3])), fmaxf(fmaxf(s[1][0], s[1][1]), fmaxf(s[1][2], s[1][3]))) * c1;
                    if (__any(mx > mrun + 8.0f)) {
                        { auto r1 = __builtin_amdgcn_permlane16_swap(__float_as_uint(mx), __float_as_uint(mx), false, false); mx = fmaxf(__uint_as_float(r1[0]), __uint_as_float(r1[1]));
                          auto r2 = __builtin_amdgcn_permlane32_swap(__float_as_uint(mx), __float_as_uint(mx), false, false); mx = fmaxf(__uint_as_float(r2[0]), __uint_as_float(r2[1])); }
                        const float mnew = fmaxf(mrun, mx); const float alpha = __builtin_amdgcn_exp2f(mrun - mnew); mrun = mnew; lrun *= alpha;
#pragma unroll
                        for (int eb = 0; eb < 16; ++eb) o[eb] = o[eb] * alpha; }
                    float p[8];
#pragma unroll
                    for (int t = 0; t < 2; ++t)
#pragma unroll
                        for (int r = 0; r < 4; ++r) p[4 * t + r] = __builtin_amdgcn_exp2f(s[t][r] * c1 - mrun);
                    lrun += ((p[0] + p[1]) + (p[2] + p[3])) + ((p[4] + p[5]) + (p[6] + p[7]));
                    v4u pk = {cvtpk(p[0], p[1]), cvtpk(p[2], p[3]), cvtpk(p[4], p[5]), cvtpk(p[6], p[7])}; const bf16x8 pb = __builtin_bit_cast(bf16x8, pk);
                    SB(); LDV(Y, hf, 1); SB();
                    MMV(X, 0); SB();
                    LDV(X, hf, 2); SB();
                    MMV(Y, 1); SB();
                    LDV(Y, hf, 3); SB();
                    MMV(X, 2); SB();
                    if (hf == 0) { LDK(X, 1, 0); SB(); }
                    MMV(Y, 3); SB();
                }
#undef LDK
#undef LDV
#undef MMK
#undef MMV
            }
#undef AT_DMA
            float lsum = lrun + __shfl_xor(lrun, 16); lsum += __shfl_xor(lsum, 32); const float inv = 1.0f / lsum;
            int lz = lane; asm volatile("" : "+v"(lz)); const int gz = lz >> 4, iz = lz & 15;
            __syncthreads();
            if (mh == 1) {
#pragma unroll
                for (int eb = 0; eb < 16; ++eb)
#pragma unroll
                    for (int r = 0; r < 4; ++r) XO[(((w - 4) * 64) + eb * 4 + r) * 64 + lz] = o[eb][r] * inv; }
            __syncthreads();
            if (mh == 0) { const float lam = LAMS[0]; float ss = 0.f;
#pragma unroll
                for (int eb = 0; eb < 16; ++eb)
#pragma unroll
                    for (int r = 0; r < 4; ++r) { const float vv = o[eb][r] * inv - lam * XO[((w * 64) + eb * 4 + r) * 64 + lz]; o[eb][r] = vv; ss += vv * vv; }
                ss += __shfl_xor(ss, 16); ss += __shfl_xor(ss, 32);
                const float rstd = (1.0f - LAMBDA_INIT) / sqrtf(ss * (1.f / 256.f) + EPS);
                bf16* op = O2 + ((size_t)b * SEQ + q0 + 16 * qb4 + iz) * D + h * 256 + 8 * gz;
#pragma unroll
                for (int pp = 0; pp < 8; ++pp) { const int e = 32 * pp + 8 * gz; const f32x4 g0 = *(const f32x4*)(subg + e), g1 = *(const f32x4*)(subg + e + 4);
                    v4u ov; ov.x = cvtpk(o[2 * pp][0] * rstd * g0[0], o[2 * pp][1] * rstd * g0[1]); ov.y = cvtpk(o[2 * pp][2] * rstd * g0[2], o[2 * pp][3] * rstd * g0[3]);
                    ov.z = cvtpk(o[2 * pp + 1][0] * rstd * g1[0], o[2 * pp + 1][1] * rstd * g1[1]); ov.w = cvtpk(o[2 * pp + 1][2] * rstd * g1[2], o[2 * pp + 1][3] * rstd * g1[3]);
                    *(v4u*)(op + 32 * pp) = ov; } }
        }
    }
}

struct Args { const float* in[22]; float* out; unsigned char* ws; };
__global__ void __launch_bounds__(NWAVES * 64, 2) yoco_fwd(Args args) {
    extern __shared__ __attribute__((aligned(16))) unsigned char lds_raw[];
    cg::grid_group grid = cg::this_grid();
    const ldsp lds = (ldsp)lds_raw;
    const int tid = threadIdx.x, lane = tid & 63, wave = __builtin_amdgcn_readfirstlane(tid >> 6);
    const int G = gridDim.x, bx = blockIdx.x; const int vcu = (G % 8 == 0) ? (bx % 8) * (G / 8) + bx / 8 : bx;
    const int gw = vcu * NWAVES + wave, NGW = G * NWAVES;
    unsigned char* ws = args.ws;
    const float* x = args.in[0]; const float* relb = args.in[1]; const float* kv_g = args.in[2]; const float* w_kv = args.in[3]; const float* w_in = args.in[4];
    const float* w_fg = args.in[5]; const float* b_fg = args.in[6]; const float* gla_ng = args.in[7]; const float* gla_wout = args.in[8]; const float* w_q = args.in[9];
    const float* lq1 = args.in[10]; const float* lk1 = args.in[11]; const float* lq2 = args.in[12]; const float* lk2 = args.in[13]; const float* subg = args.in[14];
    const float* diff_wout = args.in[15]; const float* pre_mix = args.in[16]; const float* post_mix = args.in[17]; const float* pre_ffn = args.in[18]; const float* post_ffn = args.in[19];
    const float* w_gu = args.in[20]; const float* w_dn = args.in[21];
    float* out = args.out;
    bf16* WG = (bf16*)(ws + WS_WG); bf16* WINA = (bf16*)(ws + WS_WINA); bf16* WINV = (bf16*)(ws + WS_WINV); bf16* WOUTA = (bf16*)(ws + WS_WOUTA);
    bf16* WGU0 = (bf16*)(ws + WS_WGU0); bf16* WGU1 = (bf16*)(ws + WS_WGU1); bf16* WDN0 = (bf16*)(ws + WS_WDN0); bf16* WDN1 = (bf16*)(ws + WS_WDN1);
    bf16* WKQ = (bf16*)(ws + WS_WKQ); bf16* WV = (bf16*)(ws + WS_WV); bf16* WOUTB = (bf16*)(ws + WS_WOUTB);
    bf16* BUFA = (bf16*)(ws + WS_BUFA); bf16* XN0 = (bf16*)(ws + WS_XN0); float* SQ0 = (float*)(ws + WS_SQ0); bf16* BUFB = (bf16*)(ws + WS_BUFB); float* GLR = (float*)(ws + WS_GLR); float* DECg = (float*)(ws + WS_DEC); bf16* ATTg = (bf16*)(ws + WS_ATT);
    bf16* PROJ = (bf16*)(ws + WS_R1); bf16* VTg = (bf16*)(ws + WS_VT); bf16* QDg = (bf16*)(ws + WS_QD); bf16* KETg = (bf16*)(ws + WS_KET); bf16* ACT = (bf16*)(ws + WS_R1); float* RS = (float*)(ws + WS_RS); bf16* O2B = (bf16*)(ws + WS_QD);

    for (int u = tid; u < 16; u += NWAVES * 64) ((LAS unsigned*)(lds + MISC_OFF))[u] = 0u;
    __syncthreads();
    XcdBarrier xbar = xcd_barrier_post((unsigned*)(ws + WS_CTL) + 1024, (volatile LAS unsigned*)(lds + MISC_OFF));
#define GSYNC() xcd_barrier(xbar)
    {
        LAS float* scr = (LAS float*)(lds + wave * 17408);
        constexpr int NITEMS = (2048 / 64) * ((8 * 2048) / 64) + 2 * (2048 / 64) * (11264 / 64) + 2 * (5632 / 64) * (2048 / 64);
#define SEG(W_, ldw_, col0_, K_, ncols_, gain_, dst_, mode_) if (!found_) { const int nblk_ = (ncols_) / 64, cnt_ = ((K_) / 64) * nblk_; if (r_ < cnt_) { const int kb_ = r_ / nblk_, nb_ = r_ % nblk_; \
            const float* gp_ = (gain_); dref_.src = (W_) + (size_t)(64 * kb_) * (ldw_) + (col0_) + 64 * nb_; dref_.gain = gp_ ? gp_ + 64 * kb_ : nullptr; dref_.dst = (dst_) + 64 * kb_; dref_.ldw = (ldw_); dref_.K = (K_); dref_.mode = (mode_); dref_.n0 = 64 * nb_; found_ = true; } else r_ -= cnt_; }
#define P0_DECODE(it_, dd_) do { int r_ = (it_); bool found_ = false; P0Desc& dref_ = (dd_); \
            SEG(w_gu, 11264, 0, 2048, 11264, pre_ffn, WGU0, 1) \
            SEG(w_gu + (size_t)2048 * 11264, 11264, 0, 2048, 11264, pre_ffn + D, WGU1, 1) \
            SEG(w_dn, 2048, 0, 5632, 2048, (const float*)nullptr, WDN0, 0) \
            SEG(w_dn + (size_t)5632 * 2048, 2048, 0, 5632, 2048, (const float*)nullptr, WDN1, 0) \
            SEG(w_in, GLA_IN, 0, 2048, 2048, pre_mix, WINA, 0) \
            SEG(w_in, GLA_IN, 4096, 2048, 2048, pre_mix, WINA + (size_t)2048 * 2048, 0) \
            SEG(w_in, GLA_IN, 2048, 2048, 2048, pre_mix, WINV, 0) \
            SEG(gla_wout, 2048, 0, 2048, 2048, (const float*)nullptr, WOUTA, 0) \
            SEG(w_kv, 4096, 0, 2048, 2048, kv_g, WKQ, 0) \
            SEG(w_kv, 4096, 2048, 2048, 2048, kv_g, WV, 0) \
            SEG(w_q, 2048, 0, 2048, 2048, pre_mix + D, WKQ + (size_t)2048 * 2048, 0) \
            SEG(diff_wout, 2048, 0, 2048, 2048, (const float*)nullptr, WOUTB, 0) } while (0)
        if (gw < NITEMS) {
            int it = gw; P0Desc cur, nxt; f32x4 R[16];
            P0_DECODE(it, cur); p0_load(cur, R, lane);
            for (;;) {
                p0_to_lds(R, scr, lane);
                const int nit = it + NGW; const bool more = nit < NITEMS;
                if (more) { P0_DECODE(nit, nxt); p0_load(nxt, R, lane); }
                asm volatile("s_waitcnt lgkmcnt(0)" ::: "memory");
                p0_emit(cur, scr, lane);
                asm volatile("s_waitcnt lgkmcnt(0)" ::: "memory");
                if (!more) break;
                cur = nxt; it = nit;
            }
        }
#undef SEG
#undef P0_DECODE
        for (int e = gw * 64 + lane; e < 16 * 2048; e += NGW * 64) { const int r = e >> 11, k = e & 2047; WG[e] = (bf16)(cvtpk(pre_mix[k] * w_in[(size_t)k * GLA_IN + 6144 + r], 0.f) & 0xffffu); }
        unsigned* rowctr = (unsigned*)(ws + WS_CTL) + 64;
        for (;;) { int m = 0; if (lane == 0) m = (int)atomicAdd(rowctr, 2u); m = __builtin_amdgcn_readfirstlane(m); if (m >= M) break;
            const f32x4* xr0 = (const f32x4*)(x + (size_t)m * D) + lane; const f32x4* xr1 = xr0 + D / 4;
            f32x4 v0[8], v1[8]; float s0 = 0.f, s1 = 0.f;
#pragma unroll
            for (int j = 0; j < 8; ++j) v0[j] = __builtin_nontemporal_load(xr0 + 64 * j);
#pragma unroll
            for (int j = 0; j < 8; ++j) v1[j] = __builtin_nontemporal_load(xr1 + 64 * j);
#pragma unroll
            for (int j = 0; j < 8; ++j) { s0 += (v0[j].x * v0[j].x + v0[j].y * v0[j].y) + (v0[j].z * v0[j].z + v0[j].w * v0[j].w); s1 += (v1[j].x * v1[j].x + v1[j].y * v1[j].y) + (v1[j].z * v1[j].z + v1[j].w * v1[j].w); }
            const float r0 = 1.0f / sqrtf(wave_sum(s0) * (1.f / D) + EPS), r1 = 1.0f / sqrtf(wave_sum(s1) * (1.f / D) + EPS);
            v2u* o0 = (v2u*)(XN0 + (size_t)m * D) + lane; v2u* o1 = o0 + D / 4;
            if (lane == 0) { SQ0[m] = 1.0f / r0; SQ0[m + 1] = 1.0f / r1; }
#pragma unroll
            for (int j = 0; j < 8; ++j) { v2u w; w.x = cvtpk(v0[j].x * r0, v0[j].y * r0); w.y = cvtpk(v0[j].z * r0, v0[j].w * r0); o0[64 * j] = w; }
#pragma unroll
            for (int j = 0; j < 8; ++j) { v2u w; w.x = cvtpk(v1[j].x * r1, v1[j].y * r1); w.y = cvtpk(v1[j].z * r1, v1[j].w * r1); o1[64 * j] = w; }
        }
    }
    if (gridDim.y == 4242u) grid.sync();
    GSYNC();
    {
        glr_phase(lds, XN0, WG, GLR, G, tid);
        { pg8::Gemm g{XN0, WINA, M, 4096, D}; pg8::StaticOrder S; S.init(M, 4096, G, bx); pg8::EpiBf16<0> E{PROJ, 4096, nullptr, 0, 0, 1.f};
          pg8::gemm_phase<pg8::EpiBf16<0>, pg8::StaticOrder, true, true>(lds, g, S, E); }
        { pg8::Gemm g{WINV, XN0, 2048, M, D}; pg8::StaticOrder S; S.init(2048, M, G, bx); pg8::EpiBf16<0> E{VTg, M, nullptr, 0, 0, 1.f};
          pg8::gemm_phase<pg8::EpiBf16<0>, pg8::StaticOrder, true, true>(lds, g, S, E); }
    }
    GSYNC();
#ifndef SKIP_G1
    gla_pre_phase(lds, PROJ, GLR, w_fg, b_fg, QDg, KETg, ATTg, DECg, vcu, G, tid);
#endif
    GSYNC();
#ifndef SKIP_G2
    gla_scan_phase(lds, QDg, KETg, ATTg, DECg, VTg, BUFB, vcu, G, tid);
#endif
    GSYNC();
    gla_gate_phase(BUFB, PROJ, gla_ng, BUFA, gw, NGW, lane);
    GSYNC();
    { pg8::Gemm g{BUFA, WOUTA, M, D, D}; pg8::StaticOrder S; S.init(M, D, G, bx); pg8::EpiBf16<0> E{BUFB, D, nullptr, 0, 0, 1.f};
      pg8::gemm_phase<pg8::EpiBf16<0>, pg8::StaticOrder, true, true>(lds, g, S, E); }
    GSYNC();
    norm_res_phase<false, false>(XN0, BUFB, post_mix, BUFA, RS, SQ0, gw, NGW, lane);
    GSYNC();
    { pg8::Gemm g{BUFA, WGU0, M, 2 * DFF, D}; pg8::StaticOrder S; S.init(M, 2 * DFF, G, bx); pg8::EpiSwiglu E{ACT, DFF, RS};
      pg8::gemm_phase<pg8::EpiSwiglu, pg8::StaticOrder, true, true>(lds, g, S, E); }
    GSYNC();
    { pg8::Gemm g{ACT, WDN0, M, D, DFF}; pg8::StaticOrder S; S.init(M, D, G, bx); pg8::EpiBf16<0> E{BUFB, D, nullptr, 0, 0, 1.f};
      pg8::gemm_phase<pg8::EpiBf16<0>, pg8::StaticOrder, true, true>(lds, g, S, E); }
    GSYNC();
    norm_res_phase<false, false>(BUFA, BUFB, post_ffn, BUFA, RS, nullptr, gw, NGW, lane);
    GSYNC();
    {
        { pg8::Gemm g{BUFA, WKQ, M, 4096, D}; pg8::StaticOrder S; S.init(M, 4096, G, bx); pg8::EpiBf16S E{PROJ, 4096, RS, nullptr};
          pg8::gemm_phase<pg8::EpiBf16S, pg8::StaticOrder, true, true>(lds, g, S, E); }
        { pg8::Gemm g{WV, BUFA, 2048, M, D}; pg8::StaticOrder S; S.init(2048, M, G, bx); pg8::EpiBf16S E{VTg, M, nullptr, RS};
          pg8::gemm_phase<pg8::EpiBf16S, pg8::StaticOrder, true, true>(lds, g, S, E); }
    }
    GSYNC();
#ifndef SKIP_AT
    attn_phase(lds, PROJ, VTg, relb, lq1, lk1, lq2, lk2, subg, O2B, vcu, G, tid);
#endif
    GSYNC();
    { pg8::Gemm g{O2B, WOUTB, M, D, D}; pg8::StaticOrder S; S.init(M, D, G, bx); pg8::EpiBf16<0> E{BUFB, D, nullptr, 0, 0, 1.f};
      pg8::gemm_phase<pg8::EpiBf16<0>, pg8::StaticOrder, true, true>(lds, g, S, E); }
    GSYNC();
    norm_res_phase<false, false>(BUFA, BUFB, post_mix + D, BUFA, RS, nullptr, gw, NGW, lane);
    GSYNC();
    { pg8::Gemm g{BUFA, WGU1, M, 2 * DFF, D}; pg8::StaticOrder S; S.init(M, 2 * DFF, G, bx); pg8::EpiSwiglu E{ACT, DFF, RS};
      pg8::gemm_phase<pg8::EpiSwiglu, pg8::StaticOrder, true, true>(lds, g, S, E); }
    GSYNC();
    { pg8::Gemm g{ACT, WDN1, M, D, DFF}; pg8::StaticOrder S; S.init(M, D, G, bx); pg8::EpiBf16<0> E{BUFB, D, nullptr, 0, 0, 1.f};
      pg8::gemm_phase<pg8::EpiBf16<0>, pg8::StaticOrder, true, true>(lds, g, S, E); }
    GSYNC();
    norm_res_phase<false, true>(BUFA, BUFB, post_ffn + D, out, nullptr, nullptr, gw, NGW, lane);
}

extern "C" void kernel_launch(void* const* d_in, const int* in_sizes, int n_in, void* d_out, int out_size, void* d_ws, size_t ws_size, hipStream_t stream) {
    static int grid = 0;
    if (grid == 0) {
        if (n_in != 22 || out_size != M * D || ws_size < WS_END) { fprintf(stderr, "kernel_launch: unexpected shapes (n_in %d out %d ws %zu need %zu)\n", n_in, out_size, ws_size, (size_t)WS_END); grid = -1; return; }
        int dev = 0, cus = 0, per_cu = 0;
        hipGetDevice(&dev); hipDeviceGetAttribute(&cus, hipDeviceAttributeMultiprocessorCount, dev);
        hipFuncSetAttribute((const void*)yoco_fwd, hipFuncAttributeMaxDynamicSharedMemorySize, LDS_BYTES);
        hipOccupancyMaxActiveBlocksPerMultiprocessor(&per_cu, (const void*)yoco_fwd, NWAVES * 64, LDS_BYTES);
        if (per_cu < 1) per_cu = 1;
        (void)hipGetLastError();
        grid = cus;
    }
    if (grid < 0) return;
    Args a{};
    for (int i = 0; i < 22; ++i) a.in[i] = (const float*)d_in[i];
    a.out = (float*)d_out; a.ws = (unsigned char*)d_ws;
    if (hipMemsetAsync((char*)d_ws + WS_CTL, 0, 65536, stream) != hipSuccess) { fprintf(stderr, "memset failed\n"); return; }
    void* kargs[] = {&a};
    hipError_t e = hipLaunchCooperativeKernel((const void*)yoco_fwd, dim3(grid), dim3(NWAVES * 64), kargs, LDS_BYTES, stream);
    if (e != hipSuccess) fprintf(stderr, "cooperative launch failed: %s (grid %d)\n", hipGetErrorString(e), grid);
}
```

```cpp
#include <hip/hip_runtime.h>
#include <hip/hip_cooperative_groups.h>
#include <cstdio>
#include <cstdint>
#include <cmath>
namespace cg = cooperative_groups;
namespace pg8 {
#define PG8_LAS __attribute__((address_space(3)))
typedef unsigned short bf16_t;
typedef short bf16x8 __attribute__((ext_vector_type(8)));
typedef float f32x4 __attribute__((ext_vector_type(4)));
typedef unsigned u32x4 __attribute__((ext_vector_type(4)));
constexpr int BM = 256, BK = 64, HALF = 128, HTB = HALF * BK * 2  , STAGE_BYTES = 8 * HTB, NXCD = 8, WGM = 8;

__host__ __device__ __forceinline__ int lds_byte(int r, int c) { const int st = (r >> 4) * 2 + (c >> 5), rr = r & 15, cc = c & 31, ob = rr * 64 + cc * 2; return st * 1024 + (ob ^ (((ob >> 9) & 1) << 5)); }
__host__ __device__ __forceinline__ void stage_rc(int b, int& R, int& C) { const int st = b / 1024, sb = b % 1024, swz = sb ^ (((sb >> 9) & 1) << 5); R = (st >> 1) * 16 + swz / 64; C = (st & 1) * 32 + (swz % 64) / 2; }
__host__ __device__ __forceinline__ int perm32(int rho) { const int n = rho >> 4, i = rho & 15; return 8 * (i >> 2) + 4 * n + (i & 3); }

struct Unit { int pm, pn; };
struct Gemm { const bf16_t* A; const bf16_t* Bt; int M, N, K; };

struct StaticOrder {
    int nM, nN, nwg, G, c;
    __host__ __device__ void init(int M, int N, int G_, int c_) { nM = M / BM; nN = N / BM; nwg = nM * nN; G = G_; c = c_; }
    __host__ __device__ bool next(int i, Unit& u) const {
        const long L = (long)i * G + c; if (L >= nwg) return false;
        int wgid = (int)L; { const int q = nwg / NXCD, r = nwg % NXCD, xcd = wgid % NXCD, off = wgid / NXCD; wgid = (xcd < r ? xcd * (q + 1) : r * (q + 1) + (xcd - r) * q) + off; }
        const int nig = WGM * nN, gid = wgid / nig, fm = gid * WGM, gsz = (nM - fm) < WGM ? (nM - fm) : WGM;
        u.pm = fm + ((wgid % nig) % gsz); u.pn = (wgid % nig) / gsz; return true;
    }
    __device__ __forceinline__ void a_ready(const Unit&) const {}
    __device__ __forceinline__ void done(const Unit&) const {}
};

__device__ __forceinline__ unsigned cvt_pk_bf16(float lo, float hi) { unsigned r; asm volatile("v_cvt_pk_bf16_f32 %0, %1, %2" : "=v"(r) : "v"(lo), "v"(hi)); return r; }
typedef float f32x2 __attribute__((ext_vector_type(2)));
__device__ __forceinline__ f32x2 gelu_pk(f32x2 v) {
    const f32x2 av = __builtin_elementwise_abs(v), d = av * 0.2316418882f + 1.0f;
    f32x2 t; t.x = __builtin_amdgcn_rcpf(d.x); t.y = __builtin_amdgcn_rcpf(d.y);
    f32x2 q = t * 0.5307027145f + (-0.7265760135f); q = q * t + 0.7107068705f; q = q * t + (-0.142248368f); q = q * t + 0.127414796f; q = q * t;
    const f32x2 s = (v * v) * (-0.72134752044f);
    f32x2 e; e.x = __builtin_amdgcn_exp2f(s.x); e.y = __builtin_amdgcn_exp2f(s.y);
    const f32x2 m = v * (q * e), r = v - m;
    f32x2 o; o.x = v.x < 0.f ? m.x : r.x; o.y = v.y < 0.f ? m.y : r.y; return o;
}

template <int ACT  > struct EpiBf16 {
    static constexpr bool PERM = true, AFTER_DRAIN = false; static_assert(ACT == 0 || ACT == 1, "EpiBf16: ACT is 0 (none) or 1 (gelu_pk)");
    bf16_t* O; int ldc; const float* bias; int split_cols; size_t split_stride; float scale0;
    __device__ __forceinline__ void operator()(const f32x4 (&acc)[2][2][4][2], const Unit& u, int wr, int wc, int fr, int fq) const {
        const int row0 = u.pm * BM + wr * 64 + fr; int colt = u.pn * BM; bf16_t* base = O;
        float sc = 1.f; if (split_cols) { const int t = colt / split_cols; base += (size_t)t * split_stride; colt -= t * split_cols; if (t == 0) sc = scale0; }
        const int col0 = colt + wc * 32 + 8 * fq, bcol0 = u.pn * BM + wc * 32 + 8 * fq;
        f32x4 bv[2][2];
#pragma unroll
        for (int bj = 0; bj < 2; ++bj)
#pragma unroll
            for (int n = 0; n < 2; ++n) bv[bj][n] = bias ? *(const f32x4*)(bias + bcol0 + bj * HALF + 4 * n) : (f32x4){0.f, 0.f, 0.f, 0.f};
#pragma unroll
        for (int ai = 0; ai < 2; ++ai)
#pragma unroll
            for (int m = 0; m < 4; ++m) { bf16_t* rowp = base + (size_t)(row0 + ai * HALF + m * 16) * ldc + col0;
#pragma unroll
                for (int bj = 0; bj < 2; ++bj) { f32x4 v0 = acc[ai][bj][m][0] + bv[bj][0], v1 = acc[ai][bj][m][1] + bv[bj][1];
                    if (ACT == 1) { f32x2 a = gelu_pk((f32x2){v0[0], v0[1]}), b = gelu_pk((f32x2){v0[2], v0[3]}), c = gelu_pk((f32x2){v1[0], v1[1]}), d = gelu_pk((f32x2){v1[2], v1[3]});
                        v0 = (f32x4){a.x, a.y, b.x, b.y}; v1 = (f32x4){c.x, c.y, d.x, d.y}; }
                    v0 = v0 * sc; v1 = v1 * sc; u32x4 w; w.x = cvt_pk_bf16(v0[0], v0[1]); w.y = cvt_pk_bf16(v0[2], v0[3]); w.z = cvt_pk_bf16(v1[0], v1[1]); w.w = cvt_pk_bf16(v1[2], v1[3]);
                    *(u32x4*)(rowp + bj * HALF) = w; } }
    }
};
template <class Epi, class Sched, bool ALIGN_EPI = false, bool SP2 = false>
__device__ __forceinline__ void gemm_phase(PG8_LAS unsigned char* lds, const Gemm g, const Sched& S, const Epi& E) {
    const int tid = threadIdx.x, wid = __builtin_amdgcn_readfirstlane(tid >> 6), lane = tid & 63, wr = wid >> 2, wc = wid & 3, fr = lane & 15, fq = lane >> 4;
    const int K = g.K, nt = K / BK;
    unsigned voffA[2], voffB[2];
#pragma unroll
    for (int i = 0; i < 2; ++i) { int R, C; stage_rc(tid * 16 + i * 8192, R, C); const int Rb = Epi::PERM ? ((R & ~31) + perm32(R & 31)) : R;
        voffA[i] = (unsigned)(R * K + C) * 2u; voffB[i] = (unsigned)(Rb * K + C) * 2u; }
    const size_t kstep = (size_t)(BK * 2);
    const size_t hstep = (size_t)HALF * K * 2;
    const size_t tstep = 2 * hstep;
    const unsigned ldsw = (unsigned)wid * 1024u;
    const int aoff = lds_byte(wr * 64 + fr, fq * 8), boff = lds_byte(wc * 32 + fr, fq * 8);
#define PG8_SA(b, h) (((b) * 2 + (h)) * HTB)
#define PG8_SB(b, h) ((4 + (b) * 2 + (h)) * HTB)
#define PG8_STAGE(bufoff, gbase, voff) do { _Pragma("unroll") for (int _i = 0; _i < 2; ++_i) \
        __builtin_amdgcn_global_load_lds((const unsigned*)((const char*)(gbase) + (voff)[_i]), (PG8_LAS unsigned*)(lds + (bufoff) + ldsw + _i * 8192), 16, 0, 0); } while (0)
#define PG8_LDA(dst, b, h) do { _Pragma("unroll") for (int m = 0; m < 4; ++m) _Pragma("unroll") for (int k = 0; k < 2; ++k) dst[m][k] = *(const PG8_LAS bf16x8*)(lds + PG8_SA(b, h) + aoff + m * 2048 + k * 1024); } while (0)
#define PG8_LDB(dst, b, h) do { _Pragma("unroll") for (int n = 0; n < 2; ++n) _Pragma("unroll") for (int k = 0; k < 2; ++k) dst[n][k] = *(const PG8_LAS bf16x8*)(lds + PG8_SB(b, h) + boff + n * 2048 + k * 1024); } while (0)
#define PG8_MMA(ai, bj, At, Bt) do { __builtin_amdgcn_s_setprio(1); _Pragma("unroll") for (int m = 0; m < 4; ++m) _Pragma("unroll") for (int n = 0; n < 2; ++n) _Pragma("unroll") for (int k = 0; k < 2; ++k) \
        acc[ai][bj][m][n] = __builtin_amdgcn_mfma_f32_16x16x32_bf16(Bt[n][k], At[m][k], acc[ai][bj][m][n], 0, 0, 0); __builtin_amdgcn_s_setprio(0); } while (0)
#define PG8_WAIT_V(n) asm volatile("s_waitcnt vmcnt(" #n ")" ::: "memory")
#define PG8_WAIT_L(n) asm volatile("s_waitcnt lgkmcnt(" #n ")" ::: "memory")
#define PG8_BAR __builtin_amdgcn_s_barrier()
#define PG8_SCHED __builtin_amdgcn_sched_barrier(0)
    Unit cur, nxt; int ui = 0;
    if (!S.next(0, cur)) return;
    f32x4 acc[2][2][4][2];
#pragma unroll
    for (int a = 0; a < 2; ++a)
#pragma unroll
        for (int b = 0; b < 2; ++b)
#pragma unroll
            for (int m = 0; m < 4; ++m)
#pragma unroll
                for (int n = 0; n < 2; ++n) acc[a][b][m][n] = (f32x4){0.f, 0.f, 0.f, 0.f};
    bf16x8 At[4][2], B0[2][2], B1[2][2];
    const char* cA = (const char*)g.A + (size_t)cur.pm * tstep; const char* cB = (const char*)g.Bt + (size_t)cur.pn * tstep;
    S.a_ready(cur);
    if constexpr (SP2) {
        PG8_STAGE(PG8_SB(0, 0), cB, voffB); PG8_STAGE(PG8_SB(0, 1), cB + hstep, voffB); PG8_STAGE(PG8_SA(0, 0), cA, voffA); PG8_STAGE(PG8_SA(0, 1), cA + hstep, voffA);
        if (wr == 1) PG8_BAR;
        PG8_WAIT_V(2); PG8_BAR;
        PG8_STAGE(PG8_SB(1, 0), cB + kstep, voffB); PG8_STAGE(PG8_SA(1, 0), cA + kstep, voffA); PG8_STAGE(PG8_SB(1, 1), cB + hstep + kstep, voffB);
        PG8_WAIT_V(6); PG8_BAR;
    } else {
        PG8_STAGE(PG8_SB(0, 0), cB, voffB); PG8_STAGE(PG8_SA(0, 0), cA, voffA); PG8_STAGE(PG8_SB(0, 1), cB + hstep, voffB); PG8_STAGE(PG8_SA(0, 1), cA + hstep, voffA);
        if (wr == 1) PG8_BAR;
        PG8_WAIT_V(4); PG8_BAR;
        PG8_STAGE(PG8_SB(1, 0), cB + kstep, voffB); PG8_STAGE(PG8_SA(1, 0), cA + kstep, voffA); PG8_STAGE(PG8_SB(1, 1), cB + hstep + kstep, voffB);
        PG8_WAIT_V(6); PG8_BAR;
    }
    for (;;) {
        const bool has_next = S.next(ui + 1, nxt);
        const char* nA = has_next ? (const char*)g.A + (size_t)nxt.pm * tstep : cA; const char* nB = has_next ? (const char*)g.Bt + (size_t)nxt.pn * tstep : cB;
        for (int t = 0; t < nt; t += 2) {
            const bool last = (t == nt - 2);
            const char* a1 = cA + (size_t)(t + 1) * kstep;
            const char* a2 = last ? nA : cA + (size_t)(t + 2) * kstep; const char* b2 = last ? nB : cB + (size_t)(t + 2) * kstep;
            const char* a3 = a2 + kstep; const char* b3 = b2 + kstep;
            if (last && has_next) S.a_ready(nxt);
            if constexpr (SP2) {
            PG8_LDB(B0, 0, 0); PG8_LDB(B1, 0, 1); PG8_SCHED; PG8_LDA(At, 0, 0); PG8_STAGE(PG8_SA(1, 1), a1 + hstep, voffA);
            PG8_WAIT_V(8); PG8_WAIT_L(0); PG8_BAR; PG8_MMA(0, 0, At, B0); PG8_MMA(0, 1, At, B1); PG8_BAR; PG8_SCHED;
            PG8_LDA(At, 0, 1); PG8_STAGE(PG8_SB(0, 0), b2, voffB); PG8_STAGE(PG8_SB(0, 1), b2 + hstep, voffB); PG8_STAGE(PG8_SA(0, 0), a2, voffA);
            PG8_WAIT_V(8); PG8_WAIT_L(0); PG8_BAR; PG8_MMA(1, 0, At, B0); PG8_MMA(1, 1, At, B1); PG8_BAR; PG8_SCHED;
            PG8_LDB(B0, 1, 0); PG8_LDB(B1, 1, 1); PG8_SCHED; PG8_LDA(At, 1, 0); PG8_STAGE(PG8_SA(0, 1), a2 + hstep, voffA);
            PG8_WAIT_V(8); PG8_WAIT_L(0); PG8_BAR; PG8_MMA(0, 0, At, B0); PG8_MMA(0, 1, At, B1); PG8_BAR; PG8_SCHED;
            PG8_LDA(At, 1, 1); PG8_STAGE(PG8_SB(1, 0), b3, voffB); PG8_STAGE(PG8_SB(1, 1), b3 + hstep, voffB); PG8_STAGE(PG8_SA(1, 0), a3, voffA);
            PG8_WAIT_V(8); PG8_WAIT_L(0); PG8_BAR; PG8_MMA(1, 0, At, B0); PG8_MMA(1, 1, At, B1); PG8_BAR; PG8_SCHED;
            } else {
            PG8_LDB(B0, 0, 0); PG8_SCHED; PG8_LDA(At, 0, 0); PG8_STAGE(PG8_SA(1, 1), a1 + hstep, voffA);
            PG8_WAIT_L(8); PG8_BAR; PG8_WAIT_L(0); PG8_MMA(0, 0, At, B0); PG8_BAR; PG8_SCHED;
            PG8_LDB(B1, 0, 1); PG8_STAGE(PG8_SB(0, 0), b2, voffB);
            PG8_BAR; PG8_WAIT_L(0); PG8_MMA(0, 1, At, B1); PG8_BAR;
            PG8_LDA(At, 0, 1); PG8_STAGE(PG8_SA(0, 0), a2, voffA);
            PG8_BAR; PG8_WAIT_L(0); PG8_MMA(1, 0, At, B0); PG8_BAR; PG8_SCHED;
            PG8_STAGE(PG8_SB(0, 1), b2 + hstep, voffB);
            PG8_WAIT_V(6); PG8_BAR; PG8_MMA(1, 1, At, B1); PG8_BAR;
            PG8_LDB(B0, 1, 0); PG8_SCHED; PG8_LDA(At, 1, 0); PG8_STAGE(PG8_SA(0, 1), a2 + hstep, voffA);
            PG8_WAIT_L(8); PG8_BAR; PG8_WAIT_L(0); PG8_MMA(0, 0, At, B0); PG8_BAR; PG8_SCHED;
            PG8_LDB(B1, 1, 1); PG8_STAGE(PG8_SB(1, 0), b3, voffB);
            PG8_BAR; PG8_WAIT_L(0); PG8_MMA(0, 1, At, B1); PG8_BAR;
            PG8_LDA(At, 1, 1); PG8_STAGE(PG8_SA(1, 0), a3, voffA);
            PG8_BAR; PG8_WAIT_L(0); PG8_MMA(1, 0, At, B0); PG8_BAR; PG8_SCHED;
            PG8_STAGE(PG8_SB(1, 1), b3 + hstep, voffB);
            PG8_WAIT_V(6); PG8_BAR; PG8_MMA(1, 1, At, B1); PG8_BAR;
            }
        }
        if constexpr (ALIGN_EPI) { if (wr == 0) PG8_BAR; }
        if constexpr (!Epi::AFTER_DRAIN) { E(acc, cur, wr, wc, fr, fq); S.done(cur); }
        if (!has_next) break;
#pragma unroll
        for (int a = 0; a < 2; ++a)
#pragma unroll
            for (int b = 0; b < 2; ++b)
#pragma unroll
                for (int m = 0; m < 4; ++m)
#pragma unroll
                    for (int n = 0; n < 2; ++n) acc[a][b][m][n] = (f32x4){0.f, 0.f, 0.f, 0.f};
        cur = nxt; cA = nA; cB = nB; ++ui;
        if constexpr (ALIGN_EPI) { if (wr == 1) PG8_BAR; }
    }
    PG8_WAIT_V(0);
    if constexpr (!ALIGN_EPI) { if (wr == 0) PG8_BAR; }
    PG8_BAR;
    if constexpr (Epi::AFTER_DRAIN) { E.fused(acc, cur, wr, wc, fr, fq, lds, wid, lane); S.done(cur); }
#undef PG8_SA
#undef PG8_SB
#undef PG8_STAGE
#undef PG8_LDA
#undef PG8_LDB
#undef PG8_MMA
#undef PG8_WAIT_V
#undef PG8_WAIT_L
#undef PG8_BAR
#undef PG8_SCHED
}
}

namespace pg8 {
struct EpiSwiglu {
    static constexpr bool PERM = true, AFTER_DRAIN = false;
    bf16_t* O; int ldc; const float* rs;
    __device__ __forceinline__ void operator()(const f32x4 (&acc)[2][2][4][2], const Unit& u, int wr, int wc, int fr, int fq) const {
        const int row0 = u.pm * BM + wr * 64 + fr; const int col0 = u.pn * HALF + wc * 32 + 8 * fq;
#pragma unroll
        for (int ai = 0; ai < 2; ++ai)
#pragma unroll
            for (int m = 0; m < 4; ++m) { const int r = row0 + ai * HALF + m * 16; bf16_t* rowp = O + (size_t)r * ldc + col0; const float sc = rs[r];
                float v[8];
#pragma unroll
                for (int n = 0; n < 2; ++n)
#pragma unroll
                    for (int i = 0; i < 4; ++i) { const float g = acc[ai][0][m][n][i] * sc, up = acc[ai][1][m][n][i] * sc;
                        v[n * 4 + i] = g * __builtin_amdgcn_rcpf(1.0f + __expf(-g)) * up; }
                u32x4 w; w.x = cvt_pk_bf16(v[0], v[1]); w.y = cvt_pk_bf16(v[2], v[3]); w.z = cvt_pk_bf16(v[4], v[5]); w.w = cvt_pk_bf16(v[6], v[7]);
                *(u32x4*)rowp = w; }
    }
};
struct EpiBf16S {
    static constexpr bool PERM = true, AFTER_DRAIN = false;
    bf16_t* O; int ldc; const float* rs; const float* cs;
    __device__ __forceinline__ void operator()(const f32x4 (&acc)[2][2][4][2], const Unit& u, int wr, int wc, int fr, int fq) const {
        const int row0 = u.pm * BM + wr * 64 + fr; const int col0 = u.pn * BM + wc * 32 + 8 * fq;
        f32x4 cv[2][2];
#pragma unroll
        for (int bj = 0; bj < 2; ++bj)
#pragma unroll
            for (int n = 0; n < 2; ++n) cv[bj][n] = cs ? *(const f32x4*)(cs + col0 + bj * HALF + 4 * n) : (f32x4){1.f, 1.f, 1.f, 1.f};
#pragma unroll
        for (int ai = 0; ai < 2; ++ai)
#pragma unroll
            for (int m = 0; m < 4; ++m) { const int r = row0 + ai * HALF + m * 16; bf16_t* rowp = O + (size_t)r * ldc + col0; const float sc = rs ? rs[r] : 1.f;
#pragma unroll
                for (int bj = 0; bj < 2; ++bj) { const f32x4 v0 = acc[ai][bj][m][0] * sc * cv[bj][0], v1 = acc[ai][bj][m][1] * sc * cv[bj][1];
                    u32x4 w; w.x = cvt_pk_bf16(v0[0], v0[1]); w.y = cvt_pk_bf16(v0[2], v0[3]); w.z = cvt_pk_bf16(v1[0], v1[1]); w.w = cvt_pk_bf16(v1[2], v1[3]);
                    *(u32x4*)(rowp + bj * HALF) = w; } }
    }
};
}

constexpr int NWAVES = 8;
constexpr int BATCH = 8, SEQ = 2048, D = 2048, M = BATCH * SEQ;
constexpr int DFF = 5632;
constexpr int GLA_H = 4, GLA_HK = 256, GLA_HV = 512, GLA_IN = 6160;
constexpr int DH = 8;
constexpr float EPS = 1e-6f;
constexpr float LAMBDA_INIT = 0.35550906758f;
constexpr float LOG2E = 1.4426950408889634f;

constexpr size_t MiB = 1u << 20;
constexpr size_t WS_WG = 1 * MiB;
constexpr size_t WS_WINA = 2 * MiB;
constexpr size_t WS_WINV = 18 * MiB;
constexpr size_t WS_WOUTA = 26 * MiB;
constexpr size_t WS_WGU0 = 34 * MiB, WS_WGU1 = 78 * MiB;
constexpr size_t WS_WDN0 = 122 * MiB, WS_WDN1 = 144 * MiB;
constexpr size_t WS_WKQ = 166 * MiB;
constexpr size_t WS_WV = 182 * MiB;
constexpr size_t WS_WOUTB = 190 * MiB;
constexpr size_t WS_BUFA = 198 * MiB;
constexpr size_t WS_BUFB = 262 * MiB;
constexpr size_t WS_GLR = 326 * MiB;
constexpr size_t WS_DEC = 327 * MiB;
constexpr size_t WS_RS = 1 * MiB + 131072;
constexpr size_t WS_ATT = 328 * MiB;
constexpr size_t WS_R1 = 336 * MiB;
constexpr size_t WS_VT = WS_R1 + 128 * MiB, WS_QD = WS_R1 + 192 * MiB, WS_KET = WS_R1 + 224 * MiB;
constexpr size_t WS_XN0 = WS_R1 + 256 * MiB;
constexpr size_t WS_END = WS_XN0 + 64 * MiB;
constexpr size_t WS_SQ0 = WS_RS + 65536;
constexpr int LDS_BYTES = 147456;
constexpr int MISC_OFF = LDS_BYTES - 64;
constexpr size_t WS_CTL = 0;

#define GAS __attribute__((address_space(1)))
#define LAS __attribute__((address_space(3)))
typedef unsigned short bf16;
typedef unsigned v4u __attribute__((ext_vector_type(4)));
typedef unsigned v2u __attribute__((ext_vector_type(2)));
typedef float f32x4 __attribute__((ext_vector_type(4)));
typedef float f32x16 __attribute__((ext_vector_type(16)));
typedef short bf16x8 __attribute__((ext_vector_type(8)));
typedef float f32x2_t __attribute__((ext_vector_type(2)));
typedef __bf16 bf16x2_t __attribute__((ext_vector_type(2)));
typedef LAS unsigned char* ldsp;

__device__ __forceinline__ unsigned cvtpk(float lo, float hi) { f32x2_t v = {lo, hi}; bf16x2_t b = __builtin_convertvector(v, bf16x2_t); return __builtin_bit_cast(unsigned, b); }
__device__ __forceinline__ float bflo(unsigned w) { return __uint_as_float(w << 16); }
__device__ __forceinline__ float bfhi(unsigned w) { return __uint_as_float(w & 0xffff0000u); }
__device__ __forceinline__ float bf1(bf16 b) { return __uint_as_float((unsigned)b << 16); }
__device__ __forceinline__ float wave_sum(float v) {
#pragma unroll
    for (int o = 1; o < 64; o <<= 1) v += __shfl_xor(v, o);
    return v;
}
__device__ __forceinline__ int pi32(int i) { return (i & ~12) | ((i & 4) << 1) | ((i & 8) >> 1); }
__device__ __forceinline__ bf16x8 ld8(ldsp p) { return *(const LAS bf16x8*)p; }
__device__ __forceinline__ void st16(ldsp p, v4u v) { *(LAS v4u*)p = v; }
#define MFMA32(a, b, c) __builtin_amdgcn_mfma_f32_32x32x16_bf16((a), (b), (c), 0, 0, 0)
#define MFMA16(a, b, c) __builtin_amdgcn_mfma_f32_16x16x32_bf16((a), (b), (c), 0, 0, 0)

struct P0Desc { const float* src; const float* gain; bf16* dst; int ldw, K, mode, n0; };
__device__ __forceinline__ void p0_load(const P0Desc& d, f32x4 (&R)[16], int lane) {
    const float* p = d.src + (size_t)(lane >> 4) * d.ldw + (lane & 15) * 4;
#pragma unroll
    for (int i = 0; i < 16; ++i) R[i] = __builtin_nontemporal_load((const f32x4*)(p + (size_t)(4 * i) * d.ldw));
}
__device__ __forceinline__ void p0_to_lds(const f32x4 (&R)[16], LAS float* scr, int lane) {
#pragma unroll
    for (int i = 0; i < 16; ++i) *(LAS f32x4*)(scr + (4 * i + (lane >> 4)) * 68 + (lane & 15) * 4) = R[i];
}
__device__ __forceinline__ void p0_emit(const P0Desc& d, const LAS float* scr, int lane) {
    const int c = lane & 7;
    f32x4 g0 = {1.f, 1.f, 1.f, 1.f}, g1 = g0;
    if (d.gain) { g0 = *(const f32x4*)(d.gain + 8 * c); g1 = *(const f32x4*)(d.gain + 8 * c + 4); }
#pragma unroll
    for (int j = 0; j < 8; ++j) { const int n = (lane >> 3) + 8 * j; const LAS float* s = scr + (8 * c) * 68 + n;
        v4u o; o.x = cvtpk(s[0 * 68] * g0[0], s[1 * 68] * g0[1]); o.y = cvtpk(s[2 * 68] * g0[2], s[3 * 68] * g0[3]); o.z = cvtpk(s[4 * 68] * g1[0], s[5 * 68] * g1[1]); o.w = cvtpk(s[6 * 68] * g1[2], s[7 * 68] * g1[3]);
        const int cn = d.n0 + n; int drow;
        if (d.mode == 0) drow = cn; else { const int f = cn < DFF ? cn : cn - DFF; drow = 256 * (f >> 7) + (f & 127) + (cn < DFF ? 0 : 128); }
        *(v4u*)(d.dst + (size_t)drow * d.K + 8 * c) = o; }
}

__device__ __forceinline__ void rms_row(const float* xrow, bf16* orow, int lane) {
    const f32x4* xr = (const f32x4*)xrow + lane;
    f32x4 v[8]; float s = 0.f;
#pragma unroll
    for (int j = 0; j < 8; ++j) { v[j] = xr[64 * j]; s += (v[j].x * v[j].x + v[j].y * v[j].y) + (v[j].z * v[j].z + v[j].w * v[j].w); }
    const float rstd = 1.0f / sqrtf(wave_sum(s) * (1.f / D) + EPS);
    v2u* o8 = (v2u*)orow + lane;
#pragma unroll
    for (int j = 0; j < 8; ++j) { v2u w; w.x = cvtpk(v[j].x * rstd, v[j].y * rstd); w.y = cvtpk(v[j].z * rstd, v[j].w * rstd); o8[64 * j] = w; }
}

template <bool BASE_F32, bool OUT_F32>
__device__ __forceinline__ void norm_res_phase(const void* base, const bf16* src, const float* g, void* out, float* rs, const float* bsc, int gw, int NGW, int lane) {
    const bool aff = (NGW == 2048);
    for (int it = 0, m0 = aff ? 2048 * (gw >> 8) + 2 * (gw & 255) : 2 * gw; aff ? it < 4 : m0 < M; ++it, m0 += aff ? 512 : 2 * NGW) {
        f32x4 bv[2][8]; v2u sv[2][8];
#pragma unroll
        for (int r = 0; r < 2; ++r) { const v2u* sr = (const v2u*)(src + (size_t)(m0 + r) * D) + lane;
#pragma unroll
            for (int j = 0; j < 8; ++j) sv[r][j] = __builtin_nontemporal_load(sr + 64 * j); }
#pragma unroll
        for (int r = 0; r < 2; ++r) {
            if (BASE_F32) { const f32x4* br = (const f32x4*)((const float*)base + (size_t)(m0 + r) * D) + lane;
#pragma unroll
                for (int j = 0; j < 8; ++j) bv[r][j] = __builtin_nontemporal_load(br + 64 * j); }
            else { const v2u* br = (const v2u*)((const bf16*)base + (size_t)(m0 + r) * D) + lane;
#pragma unroll
                for (int j = 0; j < 8; ++j) { const v2u w = br[64 * j]; bv[r][j] = (f32x4){bflo(w.x), bfhi(w.x), bflo(w.y), bfhi(w.y)}; }
                if (bsc) { const float sc = bsc[m0 + r];
#pragma unroll
                    for (int j = 0; j < 8; ++j) bv[r][j] = bv[r][j] * sc; } }
        }
#pragma unroll
        for (int r = 0; r < 2; ++r) {
            f32x4 v[8]; float ss = 0.f;
#pragma unroll
            for (int j = 0; j < 8; ++j) { const v2u w = sv[r][j]; v[j] = (f32x4){bflo(w.x), bfhi(w.x), bflo(w.y), bfhi(w.y)}; ss += (v[j].x * v[j].x + v[j].y * v[j].y) + (v[j].z * v[j].z + v[j].w * v[j].w); }
            const float rstd = 1.0f / sqrtf(wave_sum(ss) * (1.f / D) + EPS);
            float s2 = 0.f;
#pragma unroll
            for (int j = 0; j < 8; ++j) { const f32x4 gv = ((const f32x4*)g)[lane + 64 * j]; v[j] = bv[r][j] + v[j] * rstd * gv;
                s2 += (v[j].x * v[j].x + v[j].y * v[j].y) + (v[j].z * v[j].z + v[j].w * v[j].w); }
            if (OUT_F32) { f32x4* orow = (f32x4*)((float*)out + (size_t)(m0 + r) * D) + lane;
#pragma unroll
                for (int j = 0; j < 8; ++j) __builtin_nontemporal_store(v[j], orow + 64 * j); }
            else { v2u* orow = (v2u*)((bf16*)out + (size_t)(m0 + r) * D) + lane;
#pragma unroll
                for (int j = 0; j < 8; ++j) { v2u w; w.x = cvtpk(v[j].x, v[j].y); w.y = cvtpk(v[j].z, v[j].w); orow[64 * j] = w; } }
            if (rs) { const float r2 = 1.0f / sqrtf(wave_sum(s2) * (1.f / D) + EPS); if (lane == 0) rs[m0 + r] = r2; }
        }
    }
}

__device__ __forceinline__ void glr_phase(ldsp lds, const bf16* XN, const bf16* WG, float* GLR, int G, int tid) {
    asm volatile("" : "+v"(tid));
    const int lane = tid & 63, w = __builtin_amdgcn_readfirstlane(tid >> 6), rb = w & 3, kh = w >> 2, i = lane & 15, q = lane >> 4;
    LAS float* red = (LAS float*)lds;
    for (int blk = blockIdx.x; blk < M / 64; blk += G) {
        const bf16* ap = XN + (size_t)(blk * 64 + rb * 16 + i) * D + kh * 1024 + 8 * q;
        const bf16* bp = WG + (size_t)i * D + kh * 1024 + 8 * q;
        f32x4 acc = {0.f, 0.f, 0.f, 0.f};
#pragma unroll 8
        for (int s = 0; s < 32; ++s) { const bf16x8 a = *(const bf16x8*)(ap + 32 * s); const bf16x8 b = *(const bf16x8*)(bp + 32 * s); acc = MFMA16(a, b, acc); }
        if (kh == 1) *(LAS f32x4*)(red + (rb * 64 + lane) * 4) = acc;
        __syncthreads();
        if (kh == 0) { const f32x4 o = *(LAS f32x4*)(red + (rb * 64 + lane) * 4); acc = acc + o;
#pragma unroll
            for (int r = 0; r < 4; ++r) GLR[(size_t)(blk * 64 + rb * 16 + 4 * q + r) * 16 + i] = acc[r]; }
        __syncthreads();
    }
}

__device__ __forceinline__ void gla_pre_phase(ldsp lds, const bf16* PROJ, const float* GLR, const float* wfg, const float* bfg, bf16* QDg, bf16* KETg, bf16* ATTg, float* DECg, int vcu, int G, int tid) {
    asm volatile("" : "+v"(tid));
    const int lane = tid & 63, w = __builtin_amdgcn_readfirstlane(tid >> 6), r32 = lane & 31, hi = lane >> 5;
    const int d = tid & 255, half = tid >> 8;
    const ldsp QD = lds, KI = lds + 33792;
    LAS float* GL = (LAS float*)(lds + 67584); LAS float* TOT = (LAS float*)(lds + 71680); LAS float* RED = (LAS float*)(lds + 73728);
    v4u pq[4], pk[4]; f32x4 pg = {0.f, 0.f, 0.f, 0.f};
#define G1_PREFETCH(it_) do { const int b_ = (it_) >> 7, h_ = ((it_) >> 5) & 3, n_ = (it_) & 31; const int t0_ = b_ * SEQ + n_ * 64; \
        _Pragma("unroll") for (int cc = 0; cc < 4; ++cc) { const int idx = tid + 512 * cc; const bf16* gp = PROJ + (size_t)(t0_ + (idx >> 5)) * 4096 + h_ * 256 + (idx & 31) * 8; pq[cc] = *(const v4u*)gp; pk[cc] = *(const v4u*)(gp + 1024); } \
        if (tid < 256) pg = *(const f32x4*)(GLR + (size_t)t0_ * 16 + tid * 4); } while (0)
    if (vcu < 1024) G1_PREFETCH(vcu);
    float wf[16], bias = 0.f; int hprev = -1;
#pragma unroll
    for (int r = 0; r < 16; ++r) wf[r] = 0.f;
    for (int item = vcu; item < 1024; item += G) {
        const int b = item >> 7, h = (item >> 5) & 3, n = item & 31; const int tok0 = b * SEQ + n * 64;
#pragma unroll
        for (int cc = 0; cc < 4; ++cc) { const int idx = tid + 512 * cc, row = idx >> 5, ch = idx & 31; st16(QD + (row * 264 + ch * 8) * 2, pq[cc]); st16(KI + (row * 264 + ch * 8) * 2, pk[cc]); }
        if (tid < 256) *(LAS f32x4*)(GL + tid * 4) = pg;
        { const int nit = item + G; if (nit < 1024) G1_PREFETCH(nit); }
        if (h != hprev) { hprev = h;
#pragma unroll
            for (int r = 0; r < 16; ++r) wf[r] = wfg[r * 1024 + h * 256 + d] * LOG2E;
            bias = bfg[h * 256 + d] * LOG2E; }
        __syncthreads();
        float bc[32]; float c = 0.f;
#pragma unroll
        for (int t = 0; t < 32; ++t) { const LAS float* gr = GL + (half * 32 + t) * 16; float z = bias;
#pragma unroll
            for (int r = 0; r < 16; ++r) z += gr[r] * wf[r];
            const float ls = fmaxf(-z, 0.f) + __builtin_amdgcn_logf(1.0f + __builtin_amdgcn_exp2f(-fabsf(z)));
            c -= ls * (1.0f / 16.0f); bc[t] = c; }
        TOT[half * 256 + d] = c;
        __syncthreads();
        const float tot0 = TOT[d], tot1 = TOT[256 + d]; const float blast = tot0 + tot1; const float add = half ? tot0 : 0.f;
        unsigned ke[16];
#pragma unroll
        for (int t = 0; t < 32; ++t) { const float bcv = bc[t] + add; const int row = half * 32 + t;
            const float qv = bf1(*(const LAS bf16*)(QD + (row * 264 + d) * 2)), kv = bf1(*(const LAS bf16*)(KI + (row * 264 + d) * 2));
            const float qd = qv * 0.0625f * __builtin_amdgcn_exp2f(bcv); const float ki = kv * __builtin_amdgcn_exp2f(-bcv); const float kev = kv * __builtin_amdgcn_exp2f(blast - bcv);
            *(LAS bf16*)(QD + (row * 264 + d) * 2) = (bf16)(cvtpk(qd, 0.f) & 0xffffu);
            *(LAS bf16*)(KI + (row * 264 + d) * 2) = (bf16)(cvtpk(ki, 0.f) & 0xffffu);
            if (t & 1) ke[t >> 1] |= cvtpk(0.f, kev) & 0xffff0000u; else ke[t >> 1] = cvtpk(kev, 0.f) & 0xffffu; }
        { v4u* kp = (v4u*)(KETg + (size_t)item * 16384 + d * 64 + half * 32);
#pragma unroll
          for (int j = 0; j < 4; ++j) kp[j] = (v4u){ke[4 * j], ke[4 * j + 1], ke[4 * j + 2], ke[4 * j + 3]}; }
        if (half == 0) DECg[item * 256 + d] = __builtin_amdgcn_exp2f(blast);
        __syncthreads();
#pragma unroll
        for (int cc = 0; cc < 4; ++cc) { const int idx = tid + 512 * cc, row = idx >> 5, ch = idx & 31; *(v4u*)(QDg + (size_t)item * 16384 + row * 256 + ch * 8) = *(const LAS v4u*)(QD + (row * 264 + ch * 8) * 2); }
        { const int tile = w & 3, ti = tile >> 1, si = tile & 1, kh = w >> 2;
          f32x16 acc = {};
          const ldsp ap = KI + ((32 * si + pi32(r32)) * 264 + kh * 128 + 8 * hi) * 2; const ldsp bp = QD + ((32 * ti + r32) * 264 + kh * 128 + 8 * hi) * 2;
#pragma unroll
          for (int s = 0; s < 8; ++s) acc = MFMA32(ld8(ap + s * 32), ld8(bp + s * 32), acc);
          if (kh == 1) {
#pragma unroll
              for (int r = 0; r < 16; ++r) RED[(tile * 16 + r) * 64 + lane] = acc[r]; }
          __syncthreads();
          if (kh == 0) { const int t = 32 * ti + r32; unsigned pk[8];
#pragma unroll
              for (int r = 0; r < 16; r += 2) { float v0 = acc[r] + RED[(tile * 16 + r) * 64 + lane], v1 = acc[r + 1] + RED[(tile * 16 + r + 1) * 64 + lane];
                  const int s0 = 32 * si + 16 * (r >> 3) + 8 * hi + (r & 7);
                  if (s0 > t) v0 = 0.f; if (s0 + 1 > t) v1 = 0.f; pk[r >> 1] = cvtpk(v0, v1); }
              bf16* op = ATTg + (size_t)item * 4096 + t * 64 + 32 * si + 8 * hi;
              *(v4u*)op = (v4u){pk[0], pk[1], pk[2], pk[3]}; *(v4u*)(op + 16) = (v4u){pk[4], pk[5], pk[6], pk[7]}; }
        }
        __syncthreads();
    }
}

#undef G1_PREFETCH
__device__ __forceinline__ void gla_scan_phase(ldsp lds, const bf16* QDg, const bf16* KETg, const bf16* ATTg, const float* DECg, const bf16* VTg, bf16* O1, int vcu, int G, int tid) {
    asm volatile("" : "+v"(tid));
    const int lane = tid & 63, w = __builtin_amdgcn_readfirstlane(tid >> 6), r32 = lane & 31, hi = lane >> 5, i16 = lane & 15, q4 = lane >> 4;
    const ldsp QD = lds, KET = lds + 33792, ATT = lds + 70656, VT = lds + 79872, ST = lds + 89088; LAS float* DEC = (LAS float*)(lds + 122880);
    for (int item = vcu; item < 256; item += G) {
        const int bh = item >> 3, b = bh >> 2, h = bh & 3, j = item & 7;
        f32x16 st[2]; st[0] = (f32x16){}; st[1] = (f32x16){};
        __syncthreads();
        for (int u = tid; u < 33792 / 16; u += 512) st16(ST + u * 16, (v4u){0u, 0u, 0u, 0u});
        v4u rq[4], rk[4], ra, rv; f32x4 rd = {0.f, 0.f, 0.f, 0.f};
#define G2_LOAD(nn) do { const size_t cb = (size_t)(bh * 32 + (nn)); const int tok0_ = b * SEQ + (nn) * 64; \
        _Pragma("unroll") for (int cc = 0; cc < 4; ++cc) { rq[cc] = *(const v4u*)(QDg + cb * 16384 + (size_t)(tid + 512 * cc) * 8); rk[cc] = *(const v4u*)(KETg + cb * 16384 + (size_t)(tid + 512 * cc) * 8); } \
        ra = *(const v4u*)(ATTg + cb * 4096 + tid * 8); rv = *(const v4u*)(VTg + (size_t)(h * 512 + j * 64 + (tid >> 3)) * M + tok0_ + (tid & 7) * 8); \
        if (tid < 64) rd = *(const f32x4*)(DECg + cb * 256 + tid * 4); } while (0)
#define G2_STORE() do { _Pragma("unroll") for (int cc = 0; cc < 4; ++cc) { const int idx = tid + 512 * cc; st16(QD + ((idx >> 5) * 264 + (idx & 31) * 8) * 2, rq[cc]); st16(KET + ((idx >> 3) * 72 + (idx & 7) * 8) * 2, rk[cc]); } \
        st16(ATT + ((tid >> 3) * 72 + (tid & 7) * 8) * 2, ra); st16(VT + ((tid >> 3) * 72 + (tid & 7) * 8) * 2, rv); if (tid < 64) *(LAS f32x4*)(DEC + tid * 4) = rd; } while (0)
        G2_LOAD(0);
        G2_STORE();
        for (int n = 0; n < 32; ++n) {
            if (n + 1 < 32) G2_LOAD(n + 1);
            __syncthreads();
            { const int tb = w & 3, ebp = w >> 2; f32x4 a0 = {0.f, 0.f, 0.f, 0.f}, a1 = {0.f, 0.f, 0.f, 0.f};
              const ldsp bA = ATT + ((16 * tb + i16) * 72 + 8 * q4) * 2, bQ = QD + ((16 * tb + i16) * 264 + 8 * q4) * 2;
              const ldsp v0 = VT + ((32 * ebp + i16) * 72 + 8 * q4) * 2, v1 = v0 + 16 * 72 * 2;
              const ldsp s0 = ST + ((32 * ebp + i16) * 264 + 8 * q4) * 2, s1 = s0 + 16 * 264 * 2;
              bf16x8 bb[10], aa[8];
#pragma unroll
              for (int ks = 0; ks < 2; ++ks) bb[ks] = ld8(bA + ks * 64);
#pragma unroll
              for (int ks = 0; ks < 8; ++ks) bb[2 + ks] = ld8(bQ + ks * 64);
              aa[0] = ld8(v0); aa[1] = ld8(v1); aa[2] = ld8(v0 + 64); aa[3] = ld8(v1 + 64); aa[4] = ld8(s0); aa[5] = ld8(s1); aa[6] = ld8(s0 + 64); aa[7] = ld8(s1 + 64);
              __builtin_amdgcn_sched_barrier(0);
#pragma unroll
              for (int i = 0; i < 4; ++i) { a0 = MFMA16(aa[2 * i], bb[i], a0); a1 = MFMA16(aa[2 * i + 1], bb[i], a1); }
              __builtin_amdgcn_sched_barrier(0);
#pragma unroll
              for (int i = 0; i < 4; ++i) { aa[2 * i] = ld8(s0 + (2 + i) * 64); aa[2 * i + 1] = ld8(s1 + (2 + i) * 64); }
              __builtin_amdgcn_sched_barrier(0);
#pragma unroll
              for (int i = 0; i < 4; ++i) { a0 = MFMA16(aa[2 * i], bb[4 + i], a0); a1 = MFMA16(aa[2 * i + 1], bb[4 + i], a1); }
              __builtin_amdgcn_sched_barrier(0);
#pragma unroll
              for (int i = 0; i < 2; ++i) { aa[2 * i] = ld8(s0 + (6 + i) * 64); aa[2 * i + 1] = ld8(s1 + (6 + i) * 64); }
              __builtin_amdgcn_sched_barrier(0);
#pragma unroll
              for (int i = 0; i < 2; ++i) { a0 = MFMA16(aa[2 * i], bb[8 + i], a0); a1 = MFMA16(aa[2 * i + 1], bb[8 + i], a1); }
              __builtin_amdgcn_sched_barrier(0);
              bf16* op = O1 + (size_t)(b * SEQ + n * 64 + 16 * tb + i16) * D + h * 512 + j * 64 + 32 * ebp + 4 * q4;
              *(v2u*)op = (v2u){cvtpk(a0[0], a0[1]), cvtpk(a0[2], a0[3])}; *(v2u*)(op + 16) = (v2u){cvtpk(a1[0], a1[1]), cvtpk(a1[2], a1[3])}; }
            { float dc[16];
#pragma unroll
              for (int g = 0; g < 2; ++g) { const f32x4 x0 = *(const LAS f32x4*)(DEC + 32 * w + 16 * g + 8 * hi), x1 = *(const LAS f32x4*)(DEC + 32 * w + 16 * g + 8 * hi + 4);
                  dc[8 * g + 0] = x0[0]; dc[8 * g + 1] = x0[1]; dc[8 * g + 2] = x0[2]; dc[8 * g + 3] = x0[3]; dc[8 * g + 4] = x1[0]; dc[8 * g + 5] = x1[1]; dc[8 * g + 6] = x1[2]; dc[8 * g + 7] = x1[3]; }
              const ldsp ka = KET + ((32 * w + pi32(r32)) * 72 + 8 * hi) * 2; const ldsp vb0 = VT + (r32 * 72 + 8 * hi) * 2, vb1 = vb0 + 32 * 72 * 2;
              bf16x8 ka4[4], va4[4], vb4[4];
#pragma unroll
              for (int ks = 0; ks < 4; ++ks) { ka4[ks] = ld8(ka + ks * 32); va4[ks] = ld8(vb0 + ks * 32); vb4[ks] = ld8(vb1 + ks * 32); }
#pragma unroll
              for (int r = 0; r < 16; ++r) { st[0][r] *= dc[r]; st[1][r] *= dc[r]; }
              __builtin_amdgcn_sched_barrier(0);
#pragma unroll
              for (int ks = 0; ks < 4; ++ks) { st[0] = MFMA32(ka4[ks], va4[ks], st[0]); st[1] = MFMA32(ka4[ks], vb4[ks], st[1]); }
              __builtin_amdgcn_sched_barrier(0); }
            __syncthreads();
#pragma unroll
            for (int eb = 0; eb < 2; ++eb)
#pragma unroll
                for (int g = 0; g < 2; ++g) st16(ST + ((32 * eb + r32) * 264 + 32 * w + 16 * g + 8 * hi) * 2,
                    (v4u){cvtpk(st[eb][8 * g], st[eb][8 * g + 1]), cvtpk(st[eb][8 * g + 2], st[eb][8 * g + 3]), cvtpk(st[eb][8 * g + 4], st[eb][8 * g + 5]), cvtpk(st[eb][8 * g + 6], st[eb][8 * g + 7])});
            if (n + 1 < 32) G2_STORE();
        }
#undef G2_LOAD
#undef G2_STORE
    }
}

__device__ __forceinline__ void gla_gate_phase(const bf16* O1, const bf16* PROJ, const float* gn, bf16* A2, int gw, int NGW, int lane) {
    const f32x4 g0 = *(const f32x4*)(gn + lane * 8), g1 = *(const f32x4*)(gn + lane * 8 + 4);
    const float g[8] = {g0[0], g0[1], g0[2], g0[3], g1[0], g1[1], g1[2], g1[3]};
    for (int tok = gw; tok < M; tok += NGW) {
        v4u ov[4], rv[4];
#pragma unroll
        for (int h = 0; h < 4; ++h) { ov[h] = __builtin_nontemporal_load((const v4u*)(O1 + (size_t)tok * D + h * 512 + lane * 8)); rv[h] = __builtin_nontemporal_load((const v4u*)(PROJ + (size_t)tok * 4096 + 2048 + h * 512 + lane * 8)); }
#pragma unroll
        for (int h = 0; h < 4; ++h) {
            float o[8] = {bflo(ov[h].x), bfhi(ov[h].x), bflo(ov[h].y), bfhi(ov[h].y), bflo(ov[h].z), bfhi(ov[h].z), bflo(ov[h].w), bfhi(ov[h].w)};
            float r[8] = {bflo(rv[h].x), bfhi(rv[h].x), bflo(rv[h].y), bfhi(rv[h].y), bflo(rv[h].z), bfhi(rv[h].z), bflo(rv[h].w), bfhi(rv[h].w)};
            float ss = 0.f;
#pragma unroll
            for (int i = 0; i < 8; ++i) ss += o[i] * o[i];
            const float rstd = 1.0f / sqrtf(wave_sum(ss) * (1.f / 512.f) + EPS);
            float y[8];
#pragma unroll
            for (int i = 0; i < 8; ++i) y[i] = o[i] * rstd * g[i] * (r[i] * __builtin_amdgcn_rcpf(1.0f + __expf(-r[i])));
            *(v4u*)(A2 + (size_t)tok * D + h * 512 + lane * 8) = (v4u){cvtpk(y[0], y[1]), cvtpk(y[2], y[3]), cvtpk(y[4], y[5]), cvtpk(y[6], y[7])}; }
    }
}
#define XB_TMO      128
#define XB_XCNT(j)  (256  + 64 * (j))
#define XB_XSUB(j)  (1280 + 64 * (j))
#define XB_XGEN(j)  (2304 + 64 * (j))
#define XB_TOP      3328
#define XB_TOPGEN   3392
#define XCD_BAR_WORDS 3456
#define XB_SPIN_CAP (1u << 18)

__device__ __forceinline__ unsigned xb_ld(unsigned* p)              { return __hip_atomic_load(p, __ATOMIC_RELAXED, __HIP_MEMORY_SCOPE_AGENT); }
__device__ __forceinline__ unsigned xb_add(unsigned* p, unsigned v) { return __hip_atomic_fetch_add(p, v, __ATOMIC_RELAXED, __HIP_MEMORY_SCOPE_AGENT); }
__device__ __forceinline__ unsigned xb_xcc_id() { return (unsigned)__builtin_amdgcn_s_getreg((3 << 11) | 20) & 0xFu; }
#define XB_SPIN(cond, bar) do { unsigned _sp = 0; while (cond) { __builtin_amdgcn_s_sleep(1); \
    if ((++_sp & 255u) == 0u) { if (xb_ld(&(bar)[XB_TMO])) break; if (_sp > XB_SPIN_CAP) { atomicAdd(&(bar)[XB_TMO], 1u); break; } } } } while (0)

struct XcdBarrier {
    unsigned* bar; unsigned x;
    volatile LAS unsigned* st;
};

__device__ __forceinline__ XcdBarrier xcd_barrier_post(unsigned* bar, volatile LAS unsigned* st) {
    XcdBarrier b; b.bar = bar; b.x = xb_xcc_id(); b.st = st;
    if (threadIdx.x == 0) (void)xb_add(&bar[XB_XCNT(b.x)], 1u);
    return b;
}
__device__ __forceinline__ void xcd_barrier_complete(unsigned* bar, unsigned x, unsigned& nloc, unsigned& nx) {
    const unsigned G = gridDim.x * gridDim.y * gridDim.z;
    unsigned sum, cnt, mine, sp = 0u;
    for (;;) {
        sum = 0u; cnt = 0u; mine = 0u;
#pragma unroll
        for (unsigned j = 0; j < 16; ++j) { const unsigned c = xb_ld(&bar[XB_XCNT(j)]); sum += c; cnt += (c > 0u) ? 1u : 0u; mine = (j == x) ? c : mine; }
        if (sum == G) break;
        __builtin_amdgcn_s_sleep(1);
        if ((++sp & 255u) == 0u) { if (xb_ld(&bar[XB_TMO])) break; if (sp > XB_SPIN_CAP) { atomicAdd(&bar[XB_TMO], 1u); break; } }
    }
    nloc = mine > 0u ? mine : 1u; nx = cnt > 0u ? cnt : 1u;
}

__device__ __forceinline__ void xcd_barrier(const XcdBarrier& b) {
    asm volatile("s_waitcnt vmcnt(0)" ::: "memory");
    __syncthreads();
    if (threadIdx.x == 0) {
        unsigned* bar = b.bar;
        __builtin_amdgcn_s_waitcnt(0);
        unsigned nloc = b.st[0], nx = b.st[1];
        if (nloc == 0u) { xcd_barrier_complete(bar, b.x, nloc, nx); b.st[0] = nloc; b.st[1] = nx; }
        const unsigned old = xb_add(&bar[XB_XSUB(b.x)], 1u);
        const unsigned gen = old / nloc;
        if (old + 1u == (gen + 1u) * nloc) {
            __builtin_amdgcn_fence(__ATOMIC_RELEASE, "agent");
            asm volatile("s_waitcnt vmcnt(0)" ::: "memory");
            const unsigned og = xb_add(&bar[XB_TOP], 1u);
            const unsigned tg = og / nx;
            if (og + 1u == (tg + 1u) * nx) xb_add(&bar[XB_TOPGEN], 1u);
            else XB_SPIN(xb_ld(&bar[XB_TOPGEN]) == tg, bar);
            __builtin_amdgcn_fence(__ATOMIC_ACQUIRE, "agent");
            xb_add(&bar[XB_XGEN(b.x)], 1u);
            asm volatile("s_waitcnt vmcnt(0)" ::: "memory");
        } else {
            XB_SPIN(xb_ld(&bar[XB_XGEN(b.x)]) == gen, bar);
            __builtin_amdgcn_fence(__ATOMIC_ACQUIRE, "agent");
            asm volatile("s_waitcnt vmcnt(0)" ::: "memory");
        }
    }
    __syncthreads();
}

__device__ __forceinline__ void attn_phase(ldsp lds, const bf16* KQ, const bf16* VTa, const float* relb, const float* lq1, const float* lk1, const float* lq2, const float* lk2,
                                           const float* subg, bf16* O2, int vcu, int G, int tid) {
    asm volatile("" : "+v"(tid));
    const int lane = tid & 63, w = __builtin_amdgcn_readfirstlane(tid >> 6), i16 = lane & 15, g4 = lane >> 4;
    const int mh = w >> 2, qb4 = w & 3;
    constexpr int ABUF = 65536;
    LAS float* TB = (LAS float*)(lds + 2 * ABUF); LAS float* LAMS = (LAS float*)(lds + 2 * ABUF + 1024); LAS float* XO = (LAS float*)lds;
    if (w == 0) { float a = lq1[lane] * lk1[lane] + lq1[lane + 64] * lk1[lane + 64], b = lq2[lane] * lk2[lane] + lq2[lane + 64] * lk2[lane + 64];
        a = wave_sum(a); b = wave_sum(b); if (lane == 0) LAMS[0] = expf(a) - expf(b) + LAMBDA_INIT; }
    const float c1 = 0.08838834764831845f * LOG2E;
    for (int v = vcu; v < 256; v += G) {
        const int h = v >> 5, cq = v & 31;
        __syncthreads();
        { int t2 = tid; asm volatile("" : "+v"(t2));
          if (t2 < 129) { int bucket; if (t2 < 16) bucket = t2; else { bucket = 16 + (int)(logf((float)t2 * (1.0f / 16.0f)) / 2.0794415416798357f * 16.0f); if (bucket > 31) bucket = 31; }
            TB[t2] = relb[bucket * 8 + h] * 11.313708498984761f; } }
        for (int ui = 0; ui < 8; ++ui) {
            const int b = ui; const int qb = (ui & 1) ? 31 - cq : cq;
            const int q0 = qb * 64; const int qrow = 16 * qb4 + i16; const size_t tokq = (size_t)b * SEQ + q0 + qrow;
            bf16x8 qf[4];
#pragma unroll
            for (int ks = 0; ks < 4; ++ks) qf[ks] = *(const bf16x8*)(KQ + tokq * 4096 + 2048 + h * 256 + mh * 128 + 32 * ks + 8 * g4);
            f32x4 o[16];
#pragma unroll
            for (int eb = 0; eb < 16; ++eb) o[eb] = (f32x4){0.f, 0.f, 0.f, 0.f};
            float mrun = -INFINITY, lrun = 0.f;
            unsigned kdo[4], vdo[4];
#pragma unroll
            for (int cc = 0; cc < 4; ++cc) { const int p = 4 * w + cc;
                const int lr = 2 * p + (lane >> 5), ch = (lane & 31) ^ (lr & 15), i_ = lr & 15, t_ = (lr >> 4) & 1, gr = (lr & ~31) + 8 * (i_ >> 2) + 4 * t_ + (i_ & 3);
                kdo[cc] = (unsigned)(gr * 4096 + ch * 8);
                const int le = 8 * p + (lane >> 3), cv = (lane & 7) ^ ((le >> 1) & 7), iv = le & 15, tv = (le >> 4) & 1, ge = (le & ~31) + 8 * (iv >> 2) + 4 * tv + (iv & 3);
                vdo[cc] = (unsigned)(ge * M + cv * 8); }
#define AT_DMA(kt_, bs_) do { const bf16* kb_ = KQ + ((size_t)b * SEQ + 64 * (kt_)) * 4096 + h * 256; const bf16* vb_ = VTa + (size_t)(h * 256) * M + (size_t)b * SEQ + 64 * (kt_); \
            _Pragma("unroll") for (int cc = 0; cc < 4; ++cc) { \
                __builtin_amdgcn_global_load_lds((const unsigned*)(kb_ + kdo[cc]), (LAS unsigned*)(lds + (bs_) * ABUF + (4 * w + cc) * 1024), 16, 0, 0); \
                __builtin_amdgcn_global_load_lds((const unsigned*)(vb_ + vdo[cc]), (LAS unsigned*)(lds + (bs_) * ABUF + 32768 + (4 * w + cc) * 1024), 16, 0, 0); } } while (0)
            __syncthreads();
            AT_DMA(0, 0);
            asm volatile("s_waitcnt vmcnt(0)" : "+v"(qf[0]), "+v"(qf[1]), "+v"(qf[2]), "+v"(qf[3]) :: "memory");
            for (int kt = 0; kt <= qb; ++kt) {
                asm volatile("s_waitcnt vmcnt(0)" ::: "memory"); __syncthreads();
                if (kt + 1 <= qb) AT_DMA(kt + 1, (kt + 1) & 1);
                const ldsp Kb = lds + (kt & 1) * ABUF + i16 * 512 + mh * 256, Vb = lds + (kt & 1) * ABUF + 32768 + i16 * 128;
                const int kx = g4 ^ i16, vx = g4 ^ (i16 >> 1);
                const ldsp kbs0 = Kb + kx * 16, kbs1 = Kb + (kx ^ 4) * 16, kbs2 = Kb + (kx ^ 8) * 16, kbs3 = Kb + (kx ^ 12) * 16, vbs0 = Vb + vx * 16, vbs1 = Vb + (vx ^ 4) * 16;
                const int k0 = 64 * kt;
#define SB() __builtin_amdgcn_sched_barrier(0)
#define LDK(dst, hf_, bt_) do { _Pragma("unroll") for (int j_ = 0; j_ < 2; ++j_) _Pragma("unroll") for (int t_ = 0; t_ < 2; ++t_) dst[2 * j_ + t_] = ld8(((2 * (bt_) + j_) == 0 ? kbs0 : (2 * (bt_) + j_) == 1 ? kbs1 : (2 * (bt_) + j_) == 2 ? kbs2 : kbs3) + (32 * (hf_) + 16 * t_) * 512); } while (0)
#define LDV(dst, hf_, bt_) do { _Pragma("unroll") for (int j_ = 0; j_ < 4; ++j_) dst[j_] = ld8(((hf_) == 0 ? vbs0 : vbs1) + (4 * (bt_) + j_) * 16 * 128); } while (0)
#define MMK(src, bt_) do { s[0] = MFMA16(src[0], qf[2 * (bt_)], s[0]); s[1] = MFMA16(src[1], qf[2 * (bt_)], s[1]); s[0] = MFMA16(src[2], qf[2 * (bt_) + 1], s[0]); s[1] = MFMA16(src[3], qf[2 * (bt_) + 1], s[1]); } while (0)
#define MMV(src, bt_) do { _Pragma("unroll") for (int j_ = 0; j_ < 4; ++j_) o[4 * (bt_) + j_] = MFMA16(src[j_], pb, o[4 * (bt_) + j_]); } while (0)
                bf16x8 X[4], Y[4];
                LDK(X, 0, 0); SB();
#pragma unroll
                for (int hf = 0; hf < 2; ++hf) {
                    f32x4 s[2];
                    const int dbase = q0 + qrow - k0 - 32 * hf - 8 * g4;
                    if (q0 - k0 - 32 * hf - 31 >= 128) { const float cb = TB[128]; s[0] = (f32x4){cb, cb, cb, cb}; s[1] = s[0]; }
                    else {
#pragma unroll
                        for (int t = 0; t < 2; ++t)
#pragma unroll
                            for (int r = 0; r < 4; ++r) { const int d0 = dbase - 4 * t - r; const float b0 = TB[min(max(d0, 0), 128)]; s[t][r] = d0 < 0 ? -INFINITY : b0; }
                    }
                    SB(); LDK(Y, hf, 1); SB();
                    MMK(X, 0); SB();
                    LDV(X, hf, 0); SB();
                    MMK(Y, 1); SB();
                    float mx = fmaxf(fmaxf(fmaxf(s[0][0], s[0][1]), fmaxf(s[0][2], s[0][3])), fmaxf(fmaxf(s[1][0], s[1][1]), fmaxf(s[1][2], s[1][3]))) * c1;
                    if (__any(mx > mrun + 8.0f)) {
                        { auto r1 = __builtin_amdgcn_permlane16_swap(__float_as_uint(mx), __float_as_uint(mx), false, false); mx = fmaxf(__uint_as_float(r1[0]), __uint_as_float(r1[1]));
                          auto r2 = __builtin_amdgcn_permlane32_swap(__float_as_uint(mx), __float_as_uint(mx), false, false); mx = fmaxf(__uint_as_float(r2[0]), __uint_as_float(r2[1])); }
                        const float mnew = fmaxf(mrun, mx); const float alpha = __builtin_amdgcn_exp2f(mrun - mnew); mrun = mnew; lrun *= alpha;
#pragma unroll
                        for (int eb = 0; eb < 16; ++eb) o[eb] = o[eb] * alpha; }
                    float p[8];
#pragma unroll
                    for (int t = 0; t < 2; ++t)
#pragma unroll
                        for (int r = 0; r < 4; ++r) p[4 * t + r] = __builtin_amdgcn_exp2f(s[t][r] * c1 - mrun);
                    lrun += ((p[0] + p[1]) + (p[2] + p[3])) + ((p[4] + p[5]) + (p[6] + p[7]));
                    v4u pk = {cvtpk(p[0], p[1]), cvtpk(p[2], p[3]), cvtpk(p[4], p[5]), cvtpk(p[6], p[7])}; const bf16x8 pb = __builtin_bit_cast(bf16x8, pk);
                    SB(); LDV(Y, hf, 1); SB();
                    MMV(X, 0); SB();
                    LDV(X, hf, 2); SB();
                    MMV(Y, 1); SB();
                    LDV(Y, hf, 3); SB();
                    MMV(X, 2); SB();
                    if (hf == 0) { LDK(X, 1, 0); SB(); }
                    MMV(Y, 3); SB();
                }
#undef LDK
#undef LDV
#undef MMK
#undef MMV
            }
#undef AT_DMA
            float lsum = lrun + __shfl_xor(lrun, 16); lsum += __shfl_xor(lsum, 32); const float inv = 1.0f / lsum;
            int lz = lane; asm volatile("" : "+v"(lz)); const int gz = lz >> 4, iz = lz & 15;
            __syncthreads();
            if (mh == 1) {
#pragma unroll
                for (int eb = 0; eb < 16; ++eb)
#pragma unroll
                    for (int r = 0; r < 4; ++r) XO[(((w - 4) * 64) + eb * 4 + r) * 64 + lz] = o[eb][r] * inv; }
            __syncthreads();
            if (mh == 0) { const float lam = LAMS[0]; float ss = 0.f;
#pragma unroll
                for (int eb = 0; eb < 16; ++eb)
#pragma unroll
                    for (int r = 0; r < 4; ++r) { const float vv = o[eb][r] * inv - lam * XO[((w * 64) + eb * 4 + r) * 64 + lz]; o[eb][r] = vv; ss += vv * vv; }
                ss += __shfl_xor(ss, 16); ss += __shfl_xor(ss, 32);
                const float rstd = (1.0f - LAMBDA_INIT) / sqrtf(ss * (1.f / 256.f) + EPS);
                bf16* op = O2 + ((size_t)b * SEQ + q0 + 16 * qb4 + iz) * D + h * 256 + 8 * gz;
#pragma unroll
                for (int pp = 0; pp < 8; ++pp) { const int e = 32 * pp + 8 * gz; const f32x4 g0 = *(const f32x4*)(subg + e), g1 = *(const f32x4*)(subg + e + 4);
                    v4u ov; ov.x = cvtpk(o[2 * pp][0] * rstd * g0[0], o[2 * pp][1] * rstd * g0[1]); ov.y = cvtpk(o[2 * pp][2] * rstd * g0[2], o[2 * pp][3] * rstd * g0[3]);
                    ov.z = cvtpk(o[2 * pp + 1][0] * rstd * g1[0], o[2 * pp + 1][1] * rstd * g1[1]); ov.w = cvtpk(o[2 * pp + 1][2] * rstd * g1[2], o[2 * pp + 1][3] * rstd * g1[3]);
                    *(v4u*)(op + 32 * pp) = ov; } }
        }
    }
}

struct Args { const float* in[22]; float* out; unsigned char* ws; };
__global__ void __launch_bounds__(NWAVES * 64, 2) yoco_fwd(Args args) {
    extern __shared__ __attribute__((aligned(16))) unsigned char lds_raw[];
    cg::grid_group grid = cg::this_grid();
    const ldsp lds = (ldsp)lds_raw;
    const int tid = threadIdx.x, lane = tid & 63, wave = __builtin_amdgcn_readfirstlane(tid >> 6);
    const int G = gridDim.x, bx = blockIdx.x; const int vcu = (G % 8 == 0) ? (bx % 8) * (G / 8) + bx / 8 : bx;
    const int gw = vcu * NWAVES + wave, NGW = G * NWAVES;
    unsigned char* ws = args.ws;
    const float* x = args.in[0]; const float* relb = args.in[1]; const float* kv_g = args.in[2]; const float* w_kv = args.in[3]; const float* w_in = args.in[4];
    const float* w_fg = args.in[5]; const float* b_fg = args.in[6]; const float* gla_ng = args.in[7]; const float* gla_wout = args.in[8]; const float* w_q = args.in[9];
    const float* lq1 = args.in[10]; const float* lk1 = args.in[11]; const float* lq2 = args.in[12]; const float* lk2 = args.in[13]; const float* subg = args.in[14];
    const float* diff_wout = args.in[15]; const float* pre_mix = args.in[16]; const float* post_mix = args.in[17]; const float* pre_ffn = args.in[18]; const float* post_ffn = args.in[19];
    const float* w_gu = args.in[20]; const float* w_dn = args.in[21];
    float* out = args.out;
    bf16* WG = (bf16*)(ws + WS_WG); bf16* WINA = (bf16*)(ws + WS_WINA); bf16* WINV = (bf16*)(ws + WS_WINV); bf16* WOUTA = (bf16*)(ws + WS_WOUTA);
    bf16* WGU0 = (bf16*)(ws + WS_WGU0); bf16* WGU1 = (bf16*)(ws + WS_WGU1); bf16* WDN0 = (bf16*)(ws + WS_WDN0); bf16* WDN1 = (bf16*)(ws + WS_WDN1);
    bf16* WKQ = (bf16*)(ws + WS_WKQ); bf16* WV = (bf16*)(ws + WS_WV); bf16* WOUTB = (bf16*)(ws + WS_WOUTB);
    bf16* BUFA = (bf16*)(ws + WS_BUFA); bf16* XN0 = (bf16*)(ws + WS_XN0); float* SQ0 = (float*)(ws + WS_SQ0); bf16* BUFB = (bf16*)(ws + WS_BUFB); float* GLR = (float*)(ws + WS_GLR); float* DECg = (float*)(ws + WS_DEC); bf16* ATTg = (bf16*)(ws + WS_ATT);
    bf16* PROJ = (bf16*)(ws + WS_R1); bf16* VTg = (bf16*)(ws + WS_VT); bf16* QDg = (bf16*)(ws + WS_QD); bf16* KETg = (bf16*)(ws + WS_KET); bf16* ACT = (bf16*)(ws + WS_R1); float* RS = (float*)(ws + WS_RS); bf16* O2B = (bf16*)(ws + WS_QD);

    for (int u = tid; u < 16; u += NWAVES * 64) ((LAS unsigned*)(lds + MISC_OFF))[u] = 0u;
    __syncthreads();
    XcdBarrier xbar = xcd_barrier_post((unsigned*)(ws + WS_CTL) + 1024, (volatile LAS unsigned*)(lds + MISC_OFF));
#define GSYNC() xcd_barrier(xbar)
    {
        LAS float* scr = (LAS float*)(lds + wave * 17408);
        constexpr int NITEMS = (2048 / 64) * ((8 * 2048) / 64) + 2 * (2048 / 64) * (11264 / 64) + 2 * (5632 / 64) * (2048 / 64);
#define SEG(W_, ldw_, col0_, K_, ncols_, gain_, dst_, mode_) if (!found_) { const int nblk_ = (ncols_) / 64, cnt_ = ((K_) / 64) * nblk_; if (r_ < cnt_) { const int kb_ = r_ / nblk_, nb_ = r_ % nblk_; \
            const float* gp_ = (gain_); dref_.src = (W_) + (size_t)(64 * kb_) * (ldw_) + (col0_) + 64 * nb_; dref_.gain = gp_ ? gp_ + 64 * kb_ : nullptr; dref_.dst = (dst_) + 64 * kb_; dref_.ldw = (ldw_); dref_.K = (K_); dref_.mode = (mode_); dref_.n0 = 64 * nb_; found_ = true; } else r_ -= cnt_; }
#define P0_DECODE(it_, dd_) do { int r_ = (it_); bool found_ = false; P0Desc& dref_ = (dd_); \
            SEG(w_gu, 11264, 0, 2048, 11264, pre_ffn, WGU0, 1) \
            SEG(w_gu + (size_t)2048 * 11264, 11264, 0, 2048, 11264, pre_ffn + D, WGU1, 1) \
            SEG(w_dn, 2048, 0, 5632, 2048, (const float*)nullptr, WDN0, 0) \
            SEG(w_dn + (size_t)5632 * 2048, 2048, 0, 5632, 2048, (const float*)nullptr, WDN1, 0) \
            SEG(w_in, GLA_IN, 0, 2048, 2048, pre_mix, WINA, 0) \
            SEG(w_in, GLA_IN, 4096, 2048, 2048, pre_mix, WINA + (size_t)2048 * 2048, 0) \
            SEG(w_in, GLA_IN, 2048, 2048, 2048, pre_mix, WINV, 0) \
            SEG(gla_wout, 2048, 0, 2048, 2048, (const float*)nullptr, WOUTA, 0) \
            SEG(w_kv, 4096, 0, 2048, 2048, kv_g, WKQ, 0) \
            SEG(w_kv, 4096, 2048, 2048, 2048, kv_g, WV, 0) \
            SEG(w_q, 2048, 0, 2048, 2048, pre_mix + D, WKQ + (size_t)2048 * 2048, 0) \
            SEG(diff_wout, 2048, 0, 2048, 2048, (const float*)nullptr, WOUTB, 0) } while (0)
        if (gw < NITEMS) {
            int it = gw; P0Desc cur, nxt; f32x4 R[16];
            P0_DECODE(it, cur); p0_load(cur, R, lane);
            for (;;) {
                p0_to_lds(R, scr, lane);
                const int nit = it + NGW; const bool more = nit < NITEMS;
                if (more) { P0_DECODE(nit, nxt); p0_load(nxt, R, lane); }
                asm volatile("s_waitcnt lgkmcnt(0)" ::: "memory");
                p0_emit(cur, scr, lane);
                asm volatile("s_waitcnt lgkmcnt(0)" ::: "memory");
                if (!more) break;
                cur = nxt; it = nit;
            }
        }
#undef SEG
#undef P0_DECODE
        for (int e = gw * 64 + lane; e < 16 * 2048; e += NGW * 64) { const int r = e >> 11, k = e & 2047; WG[e] = (bf16)(cvtpk(pre_mix[k] * w_in[(size_t)k * GLA_IN + 6144 + r], 0.f) & 0xffffu); }
        for (int m = 2 * gw; m < M; m += 2 * NGW) {
            const f32x4* xr0 = (const f32x4*)(x + (size_t)m * D) + lane; const f32x4* xr1 = xr0 + D / 4;
            f32x4 v0[8], v1[8]; float s0 = 0.f, s1 = 0.f;
#pragma unroll
            for (int j = 0; j < 8; ++j) v0[j] = __builtin_nontemporal_load(xr0 + 64 * j);
#pragma unroll
            for (int j = 0; j < 8; ++j) v1[j] = __builtin_nontemporal_load(xr1 + 64 * j);
#pragma unroll
            for (int j = 0; j < 8; ++j) { s0 += (v0[j].x * v0[j].x + v0[j].y * v0[j].y) + (v0[j].z * v0[j].z + v0[j].w * v0[j].w); s1 += (v1[j].x * v1[j].x + v1[j].y * v1[j].y) + (v1[j].z * v1[j].z + v1[j].w * v1[j].w); }
            const float r0 = 1.0f / sqrtf(wave_sum(s0) * (1.f / D) + EPS), r1 = 1.0f / sqrtf(wave_sum(s1) * (1.f / D) + EPS);
            v2u* o0 = (v2u*)(XN0 + (size_t)m * D) + lane; v2u* o1 = o0 + D / 4;
            if (lane == 0) { SQ0[m] = 1.0f / r0; SQ0[m + 1] = 1.0f / r1; }
#pragma unroll
            for (int j = 0; j < 8; ++j) { v2u w; w.x = cvtpk(v0[j].x * r0, v0[j].y * r0); w.y = cvtpk(v0[j].z * r0, v0[j].w * r0); o0[64 * j] = w; }
#pragma unroll
            for (int j = 0; j < 8; ++j) { v2u w; w.x = cvtpk(v1[j].x * r1, v1[j].y * r1); w.y = cvtpk(v1[j].z * r1, v1[j].w * r1); o1[64 * j] = w; }
        }
    }
    if (gridDim.y == 4242u) grid.sync();
    GSYNC();
    {
        glr_phase(lds, XN0, WG, GLR, G, tid);
        { pg8::Gemm g{XN0, WINA, M, 4096, D}; pg8::StaticOrder S; S.init(M, 4096, G, bx); pg8::EpiBf16<0> E{PROJ, 4096, nullptr, 0, 0, 1.f};
          pg8::gemm_phase<pg8::EpiBf16<0>, pg8::StaticOrder, true, true>(lds, g, S, E); }
        { pg8::Gemm g{WINV, XN0, 2048, M, D}; pg8::StaticOrder S; S.init(2048, M, G, bx); pg8::EpiBf16<0> E{VTg, M, nullptr, 0, 0, 1.f};
          pg8::gemm_phase<pg8::EpiBf16<0>, pg8::StaticOrder, true, true>(lds, g, S, E); }
    }
    GSYNC();
#ifndef SKIP_G1
    gla_pre_phase(lds, PROJ, GLR, w_fg, b_fg, QDg, KETg, ATTg, DECg, vcu, G, tid);
#endif
    GSYNC();
#ifndef SKIP_G2
    gla_scan_phase(lds, QDg, KETg, ATTg, DECg, VTg, BUFB, vcu, G, tid);
#endif
    GSYNC();
    gla_gate_phase(BUFB, PROJ, gla_ng, BUFA, gw, NGW, lane);
    GSYNC();
    { pg8::Gemm g{BUFA, WOUTA, M, D, D}; pg8::StaticOrder S; S.init(M, D, G, bx); pg8::EpiBf16<0> E{BUFB, D, nullptr, 0, 0, 1.f};
      pg8::gemm_phase<pg8::EpiBf16<0>, pg8::StaticOrder, true, true>(lds, g, S, E); }
    GSYNC();
    norm_res_phase<false, false>(XN0, BUFB, post_mix, BUFA, RS, SQ0, gw, NGW, lane);
    GSYNC();
    { pg8::Gemm g{BUFA, WGU0, M, 2 * DFF, D}; pg8::StaticOrder S; S.init(M, 2 * DFF, G, bx); pg8::EpiSwiglu E{ACT, DFF, RS};
      pg8::gemm_phase<pg8::EpiSwiglu, pg8::StaticOrder, true, true>(lds, g, S, E); }
    GSYNC();
    { pg8::Gemm g{ACT, WDN0, M, D, DFF}; pg8::StaticOrder S; S.init(M, D, G, bx); pg8::EpiBf16<0> E{BUFB, D, nullptr, 0, 0, 1.f};
      pg8::gemm_phase<pg8::EpiBf16<0>, pg8::StaticOrder, true, true>(lds, g, S, E); }
    GSYNC();
    norm_res_phase<false, false>(BUFA, BUFB, post_ffn, BUFA, RS, nullptr, gw, NGW, lane);
    GSYNC();
    {
        { pg8::Gemm g{BUFA, WKQ, M, 4096, D}; pg8::StaticOrder S; S.init(M, 4096, G, bx); pg8::EpiBf16S E{PROJ, 4096, RS, nullptr};
          pg8::gemm_phase<pg8::EpiBf16S, pg8::StaticOrder, true, true>(lds, g, S, E); }
        { pg8::Gemm g{WV, BUFA, 2048, M, D}; pg8::StaticOrder S; S.init(2048, M, G, bx); pg8::EpiBf16S E{VTg, M, nullptr, RS};
          pg8::gemm_phase<pg8::EpiBf16S, pg8::StaticOrder, true, true>(lds, g, S, E); }
    }
    GSYNC();
#ifndef SKIP_AT
    attn_phase(lds, PROJ, VTg, relb, lq1, lk1, lq2, lk2, subg, O2B, vcu, G, tid);
#endif
    GSYNC();
    { pg8::Gemm g{O2B, WOUTB, M, D, D}; pg8::StaticOrder S; S.init(M, D, G, bx); pg8::EpiBf16<0> E{BUFB, D, nullptr, 0, 0, 1.f};
      pg8::gemm_phase<pg8::EpiBf16<0>, pg8::StaticOrder, true, true>(lds, g, S, E); }
    GSYNC();
    norm_res_phase<false, false>(BUFA, BUFB, post_mix + D, BUFA, RS, nullptr, gw, NGW, lane);
    GSYNC();
    { pg8::Gemm g{BUFA, WGU1, M, 2 * DFF, D}; pg8::StaticOrder S; S.init(M, 2 * DFF, G, bx); pg8::EpiSwiglu E{ACT, DFF, RS};
      pg8::gemm_phase<pg8::EpiSwiglu, pg8::StaticOrder, true, true>(lds, g, S, E); }
    GSYNC();
    { pg8::Gemm g{ACT, WDN1, M, D, DFF}; pg8::StaticOrder S; S.init(M, D, G, bx); pg8::EpiBf16<0> E{BUFB, D, nullptr, 0, 0, 1.f};
      pg8::gemm_phase<pg8::EpiBf16<0>, pg8::StaticOrder, true, true>(lds, g, S, E); }
    GSYNC();
    norm_res_phase<false, true>(BUFA, BUFB, post_ffn + D, out, nullptr, nullptr, gw, NGW, lane);
}

extern "C" void kernel_launch(void* const* d_in, const int* in_sizes, int n_in, void* d_out, int out_size, void* d_ws, size_t ws_size, hipStream_t stream) {
    static int grid = 0;
    if (grid == 0) {
        if (n_in != 22 || out_size != M * D || ws_size < WS_END) { fprintf(stderr, "kernel_launch: unexpected shapes (n_in %d out %d ws %zu need %zu)\n", n_in, out_size, ws_size, (size_t)WS_END); grid = -1; return; }
        int dev = 0, cus = 0, per_cu = 0;
        hipGetDevice(&dev); hipDeviceGetAttribute(&cus, hipDeviceAttributeMultiprocessorCount, dev);
        hipFuncSetAttribute((const void*)yoco_fwd, hipFuncAttributeMaxDynamicSharedMemorySize, LDS_BYTES);
        hipOccupancyMaxActiveBlocksPerMultiprocessor(&per_cu, (const void*)yoco_fwd, NWAVES * 64, LDS_BYTES);
        if (per_cu < 1) per_cu = 1;
        (void)hipGetLastError();
        grid = cus;
    }
    if (grid < 0) return;
    Args a{};
    for (int i = 0; i < 22; ++i) a.in[i] = (const float*)d_in[i];
    a.out = (float*)d_out; a.ws = (unsigned char*)d_ws;
    if (hipMemsetAsync((char*)d_ws + WS_CTL, 0, 65536, stream) != hipSuccess) { fprintf(stderr, "memset failed\n"); return; }
    void* kargs[] = {&a};
    hipError_t e = hipLaunchCooperativeKernel((const void*)yoco_fwd, dim3(grid), dim3(NWAVES * 64), kargs, LDS_BYTES, stream);
    if (e != hipSuccess) fprintf(stderr, "cooperative launch failed: %s (grid %d)\n", hipGetErrorString(e), grid);
}
```

```cpp
#include <hip/hip_runtime.h>
#include <hip/hip_cooperative_groups.h>
#include <cstdio>
#include <cstdint>
#include <cmath>
namespace cg = cooperative_groups;
namespace pg8 {
#define PG8_LAS __attribute__((address_space(3)))
typedef unsigned short bf16_t;
typedef short bf16x8 __attribute__((ext_vector_type(8)));
typedef float f32x4 __attribute__((ext_vector_type(4)));
typedef unsigned u32x4 __attribute__((ext_vector_type(4)));
constexpr int BM = 256, BK = 64, HALF = 128, HTB = HALF * BK * 2  , STAGE_BYTES = 8 * HTB, NXCD = 8, WGM = 4;

__host__ __device__ __forceinline__ int lds_byte(int r, int c) { const int st = (r >> 4) * 2 + (c >> 5), rr = r & 15, cc = c & 31, ob = rr * 64 + cc * 2; return st * 1024 + (ob ^ (((ob >> 9) & 1) << 5)); }
__host__ __device__ __forceinline__ void stage_rc(int b, int& R, int& C) { const int st = b / 1024, sb = b % 1024, swz = sb ^ (((sb >> 9) & 1) << 5); R = (st >> 1) * 16 + swz / 64; C = (st & 1) * 32 + (swz % 64) / 2; }
__host__ __device__ __forceinline__ int perm32(int rho) { const int n = rho >> 4, i = rho & 15; return 8 * (i >> 2) + 4 * n + (i & 3); }

struct Unit { int pm, pn; };
struct Gemm { const bf16_t* A; const bf16_t* Bt; int M, N, K; };

struct StaticOrder {
    int nM, nN, nwg, G, c;
    __host__ __device__ void init(int M, int N, int G_, int c_) { nM = M / BM; nN = N / BM; nwg = nM * nN; G = G_; c = c_; }
    __host__ __device__ bool next(int i, Unit& u) const {
        const long L = (long)i * G + c; if (L >= nwg) return false;
        int wgid = (int)L; { const int q = nwg / NXCD, r = nwg % NXCD, xcd = wgid % NXCD, off = wgid / NXCD; wgid = (xcd < r ? xcd * (q + 1) : r * (q + 1) + (xcd - r) * q) + off; }
        const int nig = WGM * nN, gid = wgid / nig, fm = gid * WGM, gsz = (nM - fm) < WGM ? (nM - fm) : WGM;
        u.pm = fm + ((wgid % nig) % gsz); u.pn = (wgid % nig) / gsz; return true;
    }
    __device__ __forceinline__ void a_ready(const Unit&) const {}
    __device__ __forceinline__ void done(const Unit&) const {}
};

__device__ __forceinline__ unsigned cvt_pk_bf16(float lo, float hi) { unsigned r; asm volatile("v_cvt_pk_bf16_f32 %0, %1, %2" : "=v"(r) : "v"(lo), "v"(hi)); return r; }
typedef float f32x2 __attribute__((ext_vector_type(2)));
__device__ __forceinline__ f32x2 gelu_pk(f32x2 v) {
    const f32x2 av = __builtin_elementwise_abs(v), d = av * 0.2316418882f + 1.0f;
    f32x2 t; t.x = __builtin_amdgcn_rcpf(d.x); t.y = __builtin_amdgcn_rcpf(d.y);
    f32x2 q = t * 0.5307027145f + (-0.7265760135f); q = q * t + 0.7107068705f; q = q * t + (-0.142248368f); q = q * t + 0.127414796f; q = q * t;
    const f32x2 s = (v * v) * (-0.72134752044f);
    f32x2 e; e.x = __builtin_amdgcn_exp2f(s.x); e.y = __builtin_amdgcn_exp2f(s.y);
    const f32x2 m = v * (q * e), r = v - m;
    f32x2 o; o.x = v.x < 0.f ? m.x : r.x; o.y = v.y < 0.f ? m.y : r.y; return o;
}

template <int ACT  > struct EpiBf16 {
    static constexpr bool PERM = true, AFTER_DRAIN = false; static_assert(ACT == 0 || ACT == 1, "EpiBf16: ACT is 0 (none) or 1 (gelu_pk)");
    bf16_t* O; int ldc; const float* bias; int split_cols; size_t split_stride; float scale0;
    __device__ __forceinline__ void operator()(const f32x4 (&acc)[2][2][4][2], const Unit& u, int wr, int wc, int fr, int fq) const {
        const int row0 = u.pm * BM + wr * 64 + fr; int colt = u.pn * BM; bf16_t* base = O;
        float sc = 1.f; if (split_cols) { const int t = colt / split_cols; base += (size_t)t * split_stride; colt -= t * split_cols; if (t == 0) sc = scale0; }
        const int col0 = colt + wc * 32 + 8 * fq, bcol0 = u.pn * BM + wc * 32 + 8 * fq;
        f32x4 bv[2][2];
#pragma unroll
        for (int bj = 0; bj < 2; ++bj)
#pragma unroll
            for (int n = 0; n < 2; ++n) bv[bj][n] = bias ? *(const f32x4*)(bias + bcol0 + bj * HALF + 4 * n) : (f32x4){0.f, 0.f, 0.f, 0.f};
#pragma unroll
        for (int ai = 0; ai < 2; ++ai)
#pragma unroll
            for (int m = 0; m < 4; ++m) { bf16_t* rowp = base + (size_t)(row0 + ai * HALF + m * 16) * ldc + col0;
#pragma unroll
                for (int bj = 0; bj < 2; ++bj) { f32x4 v0 = acc[ai][bj][m][0] + bv[bj][0], v1 = acc[ai][bj][m][1] + bv[bj][1];
                    if (ACT == 1) { f32x2 a = gelu_pk((f32x2){v0[0], v0[1]}), b = gelu_pk((f32x2){v0[2], v0[3]}), c = gelu_pk((f32x2){v1[0], v1[1]}), d = gelu_pk((f32x2){v1[2], v1[3]});
                        v0 = (f32x4){a.x, a.y, b.x, b.y}; v1 = (f32x4){c.x, c.y, d.x, d.y}; }
                    v0 = v0 * sc; v1 = v1 * sc; u32x4 w; w.x = cvt_pk_bf16(v0[0], v0[1]); w.y = cvt_pk_bf16(v0[2], v0[3]); w.z = cvt_pk_bf16(v1[0], v1[1]); w.w = cvt_pk_bf16(v1[2], v1[3]);
                    *(u32x4*)(rowp + bj * HALF) = w; } }
    }
};
template <class Epi, class Sched, bool ALIGN_EPI = false, bool SP2 = false>
__device__ __forceinline__ void gemm_phase(PG8_LAS unsigned char* lds, const Gemm g, const Sched& S, const Epi& E) {
    const int tid = threadIdx.x, wid = __builtin_amdgcn_readfirstlane(tid >> 6), lane = tid & 63, wr = wid >> 2, wc = wid & 3, fr = lane & 15, fq = lane >> 4;
    const int K = g.K, nt = K / BK;
    unsigned voffA[2], voffB[2];
#pragma unroll
    for (int i = 0; i < 2; ++i) { int R, C; stage_rc(tid * 16 + i * 8192, R, C); const int Rb = Epi::PERM ? ((R & ~31) + perm32(R & 31)) : R;
        voffA[i] = (unsigned)(R * K + C) * 2u; voffB[i] = (unsigned)(Rb * K + C) * 2u; }
    const size_t kstep = (size_t)(BK * 2);
    const size_t hstep = (size_t)HALF * K * 2;
    const size_t tstep = 2 * hstep;
    const unsigned ldsw = (unsigned)wid * 1024u;
    const int aoff = lds_byte(wr * 64 + fr, fq * 8), boff = lds_byte(wc * 32 + fr, fq * 8);
#define PG8_SA(b, h) (((b) * 2 + (h)) * HTB)
#define PG8_SB(b, h) ((4 + (b) * 2 + (h)) * HTB)
#define PG8_STAGE(bufoff, gbase, voff) do { _Pragma("unroll") for (int _i = 0; _i < 2; ++_i) \
        __builtin_amdgcn_global_load_lds((const unsigned*)((const char*)(gbase) + (voff)[_i]), (PG8_LAS unsigned*)(lds + (bufoff) + ldsw + _i * 8192), 16, 0, 0); } while (0)
#define PG8_LDA(dst, b, h) do { _Pragma("unroll") for (int m = 0; m < 4; ++m) _Pragma("unroll") for (int k = 0; k < 2; ++k) dst[m][k] = *(const PG8_LAS bf16x8*)(lds + PG8_SA(b, h) + aoff + m * 2048 + k * 1024); } while (0)
#define PG8_LDB(dst, b, h) do { _Pragma("unroll") for (int n = 0; n < 2; ++n) _Pragma("unroll") for (int k = 0; k < 2; ++k) dst[n][k] = *(const PG8_LAS bf16x8*)(lds + PG8_SB(b, h) + boff + n * 2048 + k * 1024); } while (0)
#define PG8_MMA(ai, bj, At, Bt) do { __builtin_amdgcn_s_setprio(1); _Pragma("unroll") for (int m = 0; m < 4; ++m) _Pragma("unroll") for (int n = 0; n < 2; ++n) _Pragma("unroll") for (int k = 0; k < 2; ++k) \
        acc[ai][bj][m][n] = __builtin_amdgcn_mfma_f32_16x16x32_bf16(Bt[n][k], At[m][k], acc[ai][bj][m][n], 0, 0, 0); __builtin_amdgcn_s_setprio(0); } while (0)
#define PG8_WAIT_V(n) asm volatile("s_waitcnt vmcnt(" #n ")" ::: "memory")
#define PG8_WAIT_L(n) asm volatile("s_waitcnt lgkmcnt(" #n ")" ::: "memory")
#define PG8_BAR __builtin_amdgcn_s_barrier()
#define PG8_SCHED __builtin_amdgcn_sched_barrier(0)
    Unit cur, nxt; int ui = 0;
    if (!S.next(0, cur)) return;
    f32x4 acc[2][2][4][2];
#pragma unroll
    for (int a = 0; a < 2; ++a)
#pragma unroll
        for (int b = 0; b < 2; ++b)
#pragma unroll
            for (int m = 0; m < 4; ++m)
#pragma unroll
                for (int n = 0; n < 2; ++n) acc[a][b][m][n] = (f32x4){0.f, 0.f, 0.f, 0.f};
    bf16x8 At[4][2], B0[2][2], B1[2][2];
    const char* cA = (const char*)g.A + (size_t)cur.pm * tstep; const char* cB = (const char*)g.Bt + (size_t)cur.pn * tstep;
    S.a_ready(cur);
    if constexpr (SP2) {
        PG8_STAGE(PG8_SB(0, 0), cB, voffB); PG8_STAGE(PG8_SB(0, 1), cB + hstep, voffB); PG8_STAGE(PG8_SA(0, 0), cA, voffA); PG8_STAGE(PG8_SA(0, 1), cA + hstep, voffA);
        if (wr == 1) PG8_BAR;
        PG8_WAIT_V(2); PG8_BAR;
        PG8_STAGE(PG8_SB(1, 0), cB + kstep, voffB); PG8_STAGE(PG8_SA(1, 0), cA + kstep, voffA); PG8_STAGE(PG8_SB(1, 1), cB + hstep + kstep, voffB);
        PG8_WAIT_V(6); PG8_BAR;
    } else {
        PG8_STAGE(PG8_SB(0, 0), cB, voffB); PG8_STAGE(PG8_SA(0, 0), cA, voffA); PG8_STAGE(PG8_SB(0, 1), cB + hstep, voffB); PG8_STAGE(PG8_SA(0, 1), cA + hstep, voffA);
        if (wr == 1) PG8_BAR;
        PG8_WAIT_V(4); PG8_BAR;
        PG8_STAGE(PG8_SB(1, 0), cB + kstep, voffB); PG8_STAGE(PG8_SA(1, 0), cA + kstep, voffA); PG8_STAGE(PG8_SB(1, 1), cB + hstep + kstep, voffB);
        PG8_WAIT_V(6); PG8_BAR;
    }
    for (;;) {
        const bool has_next = S.next(ui + 1, nxt);
        const char* nA = has_next ? (const char*)g.A + (size_t)nxt.pm * tstep : cA; const char* nB = has_next ? (const char*)g.Bt + (size_t)nxt.pn * tstep : cB;
        for (int t = 0; t < nt; t += 2) {
            const bool last = (t == nt - 2);
            const char* a1 = cA + (size_t)(t + 1) * kstep;
            const char* a2 = last ? nA : cA + (size_t)(t + 2) * kstep; const char* b2 = last ? nB : cB + (size_t)(t + 2) * kstep;
            const char* a3 = a2 + kstep; const char* b3 = b2 + kstep;
            if (last && has_next) S.a_ready(nxt);
            if constexpr (SP2) {
            PG8_LDB(B0, 0, 0); PG8_LDB(B1, 0, 1); PG8_SCHED; PG8_LDA(At, 0, 0); PG8_STAGE(PG8_SA(1, 1), a1 + hstep, voffA);
            PG8_WAIT_V(8); PG8_WAIT_L(0); PG8_BAR; PG8_MMA(0, 0, At, B0); PG8_MMA(0, 1, At, B1); PG8_BAR; PG8_SCHED;
            PG8_LDA(At, 0, 1); PG8_STAGE(PG8_SB(0, 0), b2, voffB); PG8_STAGE(PG8_SB(0, 1), b2 + hstep, voffB); PG8_STAGE(PG8_SA(0, 0), a2, voffA);
            PG8_WAIT_V(8); PG8_WAIT_L(0); PG8_BAR; PG8_MMA(1, 0, At, B0); PG8_MMA(1, 1, At, B1); PG8_BAR; PG8_SCHED;
            PG8_LDB(B0, 1, 0); PG8_LDB(B1, 1, 1); PG8_SCHED; PG8_LDA(At, 1, 0); PG8_STAGE(PG8_SA(0, 1), a2 + hstep, voffA);
            PG8_WAIT_V(8); PG8_WAIT_L(0); PG8_BAR; PG8_MMA(0, 0, At, B0); PG8_MMA(0, 1, At, B1); PG8_BAR; PG8_SCHED;
            PG8_LDA(At, 1, 1); PG8_STAGE(PG8_SB(1, 0), b3, voffB); PG8_STAGE(PG8_SB(1, 1), b3 + hstep, voffB); PG8_STAGE(PG8_SA(1, 0), a3, voffA);
            PG8_WAIT_V(8); PG8_WAIT_L(0); PG8_BAR; PG8_MMA(1, 0, At, B0); PG8_MMA(1, 1, At, B1); PG8_BAR; PG8_SCHED;
            } else {
            PG8_LDB(B0, 0, 0); PG8_SCHED; PG8_LDA(At, 0, 0); PG8_STAGE(PG8_SA(1, 1), a1 + hstep, voffA);
            PG8_WAIT_L(8); PG8_BAR; PG8_WAIT_L(0); PG8_MMA(0, 0, At, B0); PG8_BAR; PG8_SCHED;
            PG8_LDB(B1, 0, 1); PG8_STAGE(PG8_SB(0, 0), b2, voffB);
            PG8_BAR; PG8_WAIT_L(0); PG8_MMA(0, 1, At, B1); PG8_BAR;
            PG8_LDA(At, 0, 1); PG8_STAGE(PG8_SA(0, 0), a2, voffA);
            PG8_BAR; PG8_WAIT_L(0); PG8_MMA(1, 0, At, B0); PG8_BAR; PG8_SCHED;
            PG8_STAGE(PG8_SB(0, 1), b2 + hstep, voffB);
            PG8_WAIT_V(6); PG8_BAR; PG8_MMA(1, 1, At, B1); PG8_BAR;
            PG8_LDB(B0, 1, 0); PG8_SCHED; PG8_LDA(At, 1, 0); PG8_STAGE(PG8_SA(0, 1), a2 + hstep, voffA);
            PG8_WAIT_L(8); PG8_BAR; PG8_WAIT_L(0); PG8_MMA(0, 0, At, B0); PG8_BAR; PG8_SCHED;
            PG8_LDB(B1, 1, 1); PG8_STAGE(PG8_SB(1, 0), b3, voffB);
            PG8_BAR; PG8_WAIT_L(0); PG8_MMA(0, 1, At, B1); PG8_BAR;
            PG8_LDA(At, 1, 1); PG8_STAGE(PG8_SA(1, 0), a3, voffA);
            PG8_BAR; PG8_WAIT_L(0); PG8_MMA(1, 0, At, B0); PG8_BAR; PG8_SCHED;
            PG8_STAGE(PG8_SB(1, 1), b3 + hstep, voffB);
            PG8_WAIT_V(6); PG8_BAR; PG8_MMA(1, 1, At, B1); PG8_BAR;
            }
        }
        if constexpr (ALIGN_EPI) { if (wr == 0) PG8_BAR; }
        if constexpr (!Epi::AFTER_DRAIN) { E(acc, cur, wr, wc, fr, fq); S.done(cur); }
        if (!has_next) break;
#pragma unroll
        for (int a = 0; a < 2; ++a)
#pragma unroll
            for (int b = 0; b < 2; ++b)
#pragma unroll
                for (int m = 0; m < 4; ++m)
#pragma unroll
                    for (int n = 0; n < 2; ++n) acc[a][b][m][n] = (f32x4){0.f, 0.f, 0.f, 0.f};
        cur = nxt; cA = nA; cB = nB; ++ui;
        if constexpr (ALIGN_EPI) { if (wr == 1) PG8_BAR; }
    }
    PG8_WAIT_V(0);
    if constexpr (!ALIGN_EPI) { if (wr == 0) PG8_BAR; }
    PG8_BAR;
    if constexpr (Epi::AFTER_DRAIN) { E.fused(acc, cur, wr, wc, fr, fq, lds, wid, lane); S.done(cur); }
#undef PG8_SA
#undef PG8_SB
#undef PG8_STAGE
#undef PG8_LDA
#undef PG8_LDB
#undef PG8_MMA
#undef PG8_WAIT_V
#undef PG8_WAIT_L
#undef PG8_BAR
#undef PG8_SCHED
}
}

namespace pg8 {
struct EpiSwiglu {
    static constexpr bool PERM = true, AFTER_DRAIN = false;
    bf16_t* O; int ldc; const float* rs;
    __device__ __forceinline__ void operator()(const f32x4 (&acc)[2][2][4][2], const Unit& u, int wr, int wc, int fr, int fq) const {
        const int row0 = u.pm * BM + wr * 64 + fr; const int col0 = u.pn * HALF + wc * 32 + 8 * fq;
#pragma unroll
        for (int ai = 0; ai < 2; ++ai)
#pragma unroll
            for (int m = 0; m < 4; ++m) { const int r = row0 + ai * HALF + m * 16; bf16_t* rowp = O + (size_t)r * ldc + col0; const float sc = rs[r];
                float v[8];
#pragma unroll
                for (int n = 0; n < 2; ++n)
#pragma unroll
                    for (int i = 0; i < 4; ++i) { const float g = acc[ai][0][m][n][i] * sc, up = acc[ai][1][m][n][i] * sc;
                        v[n * 4 + i] = g * __builtin_amdgcn_rcpf(1.0f + __expf(-g)) * up; }
                u32x4 w; w.x = cvt_pk_bf16(v[0], v[1]); w.y = cvt_pk_bf16(v[2], v[3]); w.z = cvt_pk_bf16(v[4], v[5]); w.w = cvt_pk_bf16(v[6], v[7]);
                *(u32x4*)rowp = w; }
    }
};
struct EpiBf16S {
    static constexpr bool PERM = true, AFTER_DRAIN = false;
    bf16_t* O; int ldc; const float* rs; const float* cs;
    __device__ __forceinline__ void operator()(const f32x4 (&acc)[2][2][4][2], const Unit& u, int wr, int wc, int fr, int fq) const {
        const int row0 = u.pm * BM + wr * 64 + fr; const int col0 = u.pn * BM + wc * 32 + 8 * fq;
        f32x4 cv[2][2];
#pragma unroll
        for (int bj = 0; bj < 2; ++bj)
#pragma unroll
            for (int n = 0; n < 2; ++n) cv[bj][n] = cs ? *(const f32x4*)(cs + col0 + bj * HALF + 4 * n) : (f32x4){1.f, 1.f, 1.f, 1.f};
#pragma unroll
        for (int ai = 0; ai < 2; ++ai)
#pragma unroll
            for (int m = 0; m < 4; ++m) { const int r = row0 + ai * HALF + m * 16; bf16_t* rowp = O + (size_t)r * ldc + col0; const float sc = rs ? rs[r] : 1.f;
#pragma unroll
                for (int bj = 0; bj < 2; ++bj) { const f32x4 v0 = acc[ai][bj][m][0] * sc * cv[bj][0], v1 = acc[ai][bj][m][1] * sc * cv[bj][1];
                    u32x4 w; w.x = cvt_pk_bf16(v0[0], v0[1]); w.y = cvt_pk_bf16(v0[2], v0[3]); w.z = cvt_pk_bf16(v1[0], v1[1]); w.w = cvt_pk_bf16(v1[2], v1[3]);
                    *(u32x4*)(rowp + bj * HALF) = w; } }
    }
};
}

constexpr int NWAVES = 8;
constexpr int BATCH = 8, SEQ = 2048, D = 2048, M = BATCH * SEQ;
constexpr int DFF = 5632;
constexpr int GLA_H = 4, GLA_HK = 256, GLA_HV = 512, GLA_IN = 6160;
constexpr int DH = 8;
constexpr float EPS = 1e-6f;
constexpr float LAMBDA_INIT = 0.35550906758f;
constexpr float LOG2E = 1.4426950408889634f;

constexpr size_t MiB = 1u << 20;
constexpr size_t WS_WG = 1 * MiB;
constexpr size_t WS_WINA = 2 * MiB;
constexpr size_t WS_WINV = 18 * MiB;
constexpr size_t WS_WOUTA = 26 * MiB;
constexpr size_t WS_WGU0 = 34 * MiB, WS_WGU1 = 78 * MiB;
constexpr size_t WS_WDN0 = 122 * MiB, WS_WDN1 = 144 * MiB;
constexpr size_t WS_WKQ = 166 * MiB;
constexpr size_t WS_WV = 182 * MiB;
constexpr size_t WS_WOUTB = 190 * MiB;
constexpr size_t WS_BUFA = 198 * MiB;
constexpr size_t WS_BUFB = 262 * MiB;
constexpr size_t WS_GLR = 326 * MiB;
constexpr size_t WS_DEC = 327 * MiB;
constexpr size_t WS_RS = 1 * MiB + 131072;
constexpr size_t WS_ATT = 328 * MiB;
constexpr size_t WS_R1 = 336 * MiB;
constexpr size_t WS_VT = WS_R1 + 128 * MiB, WS_QD = WS_R1 + 192 * MiB, WS_KET = WS_R1 + 224 * MiB;
constexpr size_t WS_XN0 = WS_R1 + 256 * MiB;
constexpr size_t WS_END = WS_XN0 + 64 * MiB;
constexpr size_t WS_SQ0 = WS_RS + 65536;
constexpr int LDS_BYTES = 147456;
constexpr int MISC_OFF = LDS_BYTES - 64;
constexpr size_t WS_CTL = 0;

#define GAS __attribute__((address_space(1)))
#define LAS __attribute__((address_space(3)))
typedef unsigned short bf16;
typedef unsigned v4u __attribute__((ext_vector_type(4)));
typedef unsigned v2u __attribute__((ext_vector_type(2)));
typedef float f32x4 __attribute__((ext_vector_type(4)));
typedef float f32x16 __attribute__((ext_vector_type(16)));
typedef short bf16x8 __attribute__((ext_vector_type(8)));
typedef float f32x2_t __attribute__((ext_vector_type(2)));
typedef __bf16 bf16x2_t __attribute__((ext_vector_type(2)));
typedef LAS unsigned char* ldsp;

__device__ __forceinline__ unsigned cvtpk(float lo, float hi) { f32x2_t v = {lo, hi}; bf16x2_t b = __builtin_convertvector(v, bf16x2_t); return __builtin_bit_cast(unsigned, b); }
__device__ __forceinline__ float bflo(unsigned w) { return __uint_as_float(w << 16); }
__device__ __forceinline__ float bfhi(unsigned w) { return __uint_as_float(w & 0xffff0000u); }
__device__ __forceinline__ float bf1(bf16 b) { return __uint_as_float((unsigned)b << 16); }
__device__ __forceinline__ float wave_sum(float v) {
#pragma unroll
    for (int o = 1; o < 64; o <<= 1) v += __shfl_xor(v, o);
    return v;
}
__device__ __forceinline__ int pi32(int i) { return (i & ~12) | ((i & 4) << 1) | ((i & 8) >> 1); }
__device__ __forceinline__ bf16x8 ld8(ldsp p) { return *(const LAS bf16x8*)p; }
__device__ __forceinline__ void st16(ldsp p, v4u v) { *(LAS v4u*)p = v; }
#define MFMA32(a, b, c) __builtin_amdgcn_mfma_f32_32x32x16_bf16((a), (b), (c), 0, 0, 0)
#define MFMA16(a, b, c) __builtin_amdgcn_mfma_f32_16x16x32_bf16((a), (b), (c), 0, 0, 0)

struct P0Desc { const float* src; const float* gain; bf16* dst; int ldw, K, mode, n0; };
__device__ __forceinline__ void p0_load(const P0Desc& d, f32x4 (&R)[16], int lane) {
    const float* p = d.src + (size_t)(lane >> 4) * d.ldw + (lane & 15) * 4;
#pragma unroll
    for (int i = 0; i < 16; ++i) R[i] = __builtin_nontemporal_load((const f32x4*)(p + (size_t)(4 * i) * d.ldw));
}
__device__ __forceinline__ void p0_to_lds(const f32x4 (&R)[16], LAS float* scr, int lane) {
#pragma unroll
    for (int i = 0; i < 16; ++i) *(LAS f32x4*)(scr + (4 * i + (lane >> 4)) * 68 + (lane & 15) * 4) = R[i];
}
__device__ __forceinline__ void p0_emit(const P0Desc& d, const LAS float* scr, int lane) {
    const int c = lane & 7;
    f32x4 g0 = {1.f, 1.f, 1.f, 1.f}, g1 = g0;
    if (d.gain) { g0 = *(const f32x4*)(d.gain + 8 * c); g1 = *(const f32x4*)(d.gain + 8 * c + 4); }
#pragma unroll
    for (int j = 0; j < 8; ++j) { const int n = (lane >> 3) + 8 * j; const LAS float* s = scr + (8 * c) * 68 + n;
        v4u o; o.x = cvtpk(s[0 * 68] * g0[0], s[1 * 68] * g0[1]); o.y = cvtpk(s[2 * 68] * g0[2], s[3 * 68] * g0[3]); o.z = cvtpk(s[4 * 68] * g1[0], s[5 * 68] * g1[1]); o.w = cvtpk(s[6 * 68] * g1[2], s[7 * 68] * g1[3]);
        const int cn = d.n0 + n; int drow;
        if (d.mode == 0) drow = cn; else { const int f = cn < DFF ? cn : cn - DFF; drow = 256 * (f >> 7) + (f & 127) + (cn < DFF ? 0 : 128); }
        *(v4u*)(d.dst + (size_t)drow * d.K + 8 * c) = o; }
}

__device__ __forceinline__ void rms_row(const float* xrow, bf16* orow, int lane) {
    const f32x4* xr = (const f32x4*)xrow + lane;
    f32x4 v[8]; float s = 0.f;
#pragma unroll
    for (int j = 0; j < 8; ++j) { v[j] = xr[64 * j]; s += (v[j].x * v[j].x + v[j].y * v[j].y) + (v[j].z * v[j].z + v[j].w * v[j].w); }
    const float rstd = 1.0f / sqrtf(wave_sum(s) * (1.f / D) + EPS);
    v2u* o8 = (v2u*)orow + lane;
#pragma unroll
    for (int j = 0; j < 8; ++j) { v2u w; w.x = cvtpk(v[j].x * rstd, v[j].y * rstd); w.y = cvtpk(v[j].z * rstd, v[j].w * rstd); o8[64 * j] = w; }
}

template <bool BASE_F32, bool OUT_F32>
__device__ __forceinline__ void norm_res_phase(const void* base, const bf16* src, const float* g, void* out, float* rs, const float* bsc, int gw, int NGW, int lane) {
    for (int m0 = 2 * gw; m0 < M; m0 += 2 * NGW) {
        f32x4 bv[2][8]; v2u sv[2][8];
#pragma unroll
        for (int r = 0; r < 2; ++r) { const v2u* sr = (const v2u*)(src + (size_t)(m0 + r) * D) + lane;
#pragma unroll
            for (int j = 0; j < 8; ++j) sv[r][j] = __builtin_nontemporal_load(sr + 64 * j); }
#pragma unroll
        for (int r = 0; r < 2; ++r) {
            if (BASE_F32) { const f32x4* br = (const f32x4*)((const float*)base + (size_t)(m0 + r) * D) + lane;
#pragma unroll
                for (int j = 0; j < 8; ++j) bv[r][j] = __builtin_nontemporal_load(br + 64 * j); }
            else { const v2u* br = (const v2u*)((const bf16*)base + (size_t)(m0 + r) * D) + lane;
#pragma unroll
                for (int j = 0; j < 8; ++j) { const v2u w = br[64 * j]; bv[r][j] = (f32x4){bflo(w.x), bfhi(w.x), bflo(w.y), bfhi(w.y)}; }
                if (bsc) { const float sc = bsc[m0 + r];
#pragma unroll
                    for (int j = 0; j < 8; ++j) bv[r][j] = bv[r][j] * sc; } }
        }
#pragma unroll
        for (int r = 0; r < 2; ++r) {
            f32x4 v[8]; float ss = 0.f;
#pragma unroll
            for (int j = 0; j < 8; ++j) { const v2u w = sv[r][j]; v[j] = (f32x4){bflo(w.x), bfhi(w.x), bflo(w.y), bfhi(w.y)}; ss += (v[j].x * v[j].x + v[j].y * v[j].y) + (v[j].z * v[j].z + v[j].w * v[j].w); }
            const float rstd = 1.0f / sqrtf(wave_sum(ss) * (1.f / D) + EPS);
            float s2 = 0.f;
#pragma unroll
            for (int j = 0; j < 8; ++j) { const f32x4 gv = ((const f32x4*)g)[lane + 64 * j]; v[j] = bv[r][j] + v[j] * rstd * gv;
                s2 += (v[j].x * v[j].x + v[j].y * v[j].y) + (v[j].z * v[j].z + v[j].w * v[j].w); }
            if (OUT_F32) { f32x4* orow = (f32x4*)((float*)out + (size_t)(m0 + r) * D) + lane;
#pragma unroll
                for (int j = 0; j < 8; ++j) __builtin_nontemporal_store(v[j], orow + 64 * j); }
            else { v2u* orow = (v2u*)((bf16*)out + (size_t)(m0 + r) * D) + lane;
#pragma unroll
                for (int j = 0; j < 8; ++j) { v2u w; w.x = cvtpk(v[j].x, v[j].y); w.y = cvtpk(v[j].z, v[j].w); orow[64 * j] = w; } }
            if (rs) { const float r2 = 1.0f / sqrtf(wave_sum(s2) * (1.f / D) + EPS); if (lane == 0) rs[m0 + r] = r2; }
        }
    }
}

__device__ __forceinline__ void glr_phase(ldsp lds, const bf16* XN, const bf16* WG, float* GLR, int G, int tid) {
    asm volatile("" : "+v"(tid));
    const int lane = tid & 63, w = __builtin_amdgcn_readfirstlane(tid >> 6), rb = w & 3, kh = w >> 2, i = lane & 15, q = lane >> 4;
    LAS float* red = (LAS float*)lds;
    for (int blk = blockIdx.x; blk < M / 64; blk += G) {
        const bf16* ap = XN + (size_t)(blk * 64 + rb * 16 + i) * D + kh * 1024 + 8 * q;
        const bf16* bp = WG + (size_t)i * D + kh * 1024 + 8 * q;
        f32x4 acc = {0.f, 0.f, 0.f, 0.f};
#pragma unroll 8
        for (int s = 0; s < 32; ++s) { const bf16x8 a = *(const bf16x8*)(ap + 32 * s); const bf16x8 b = *(const bf16x8*)(bp + 32 * s); acc = MFMA16(a, b, acc); }
        if (kh == 1) *(LAS f32x4*)(red + (rb * 64 + lane) * 4) = acc;
        __syncthreads();
        if (kh == 0) { const f32x4 o = *(LAS f32x4*)(red + (rb * 64 + lane) * 4); acc = acc + o;
#pragma unroll
            for (int r = 0; r < 4; ++r) GLR[(size_t)(blk * 64 + rb * 16 + 4 * q + r) * 16 + i] = acc[r]; }
        __syncthreads();
    }
}

__device__ __forceinline__ void gla_pre_phase(ldsp lds, const bf16* PROJ, const float* GLR, const float* wfg, const float* bfg, bf16* QDg, bf16* KETg, bf16* ATTg, float* DECg, int vcu, int G, int tid) {
    asm volatile("" : "+v"(tid));
    const int lane = tid & 63, w = __builtin_amdgcn_readfirstlane(tid >> 6), r32 = lane & 31, hi = lane >> 5;
    const int d = tid & 255, half = tid >> 8;
    const ldsp QD = lds, KI = lds + 33792;
    LAS float* GL = (LAS float*)(lds + 67584); LAS float* TOT = (LAS float*)(lds + 71680); LAS float* RED = (LAS float*)(lds + 73728);
    v4u pq[4], pk[4]; f32x4 pg = {0.f, 0.f, 0.f, 0.f};
#define G1_PREFETCH(it_) do { const int b_ = (it_) >> 7, h_ = ((it_) >> 5) & 3, n_ = (it_) & 31; const int t0_ = b_ * SEQ + n_ * 64; \
        _Pragma("unroll") for (int cc = 0; cc < 4; ++cc) { const int idx = tid + 512 * cc; const bf16* gp = PROJ + (size_t)(t0_ + (idx >> 5)) * 4096 + h_ * 256 + (idx & 31) * 8; pq[cc] = *(const v4u*)gp; pk[cc] = *(const v4u*)(gp + 1024); } \
        if (tid < 256) pg = *(const f32x4*)(GLR + (size_t)t0_ * 16 + tid * 4); } while (0)
    if (vcu < 1024) G1_PREFETCH(vcu);
    float wf[16], bias = 0.f; int hprev = -1;
#pragma unroll
    for (int r = 0; r < 16; ++r) wf[r] = 0.f;
    for (int item = vcu; item < 1024; item += G) {
        const int b = item >> 7, h = (item >> 5) & 3, n = item & 31; const int tok0 = b * SEQ + n * 64;
#pragma unroll
        for (int cc = 0; cc < 4; ++cc) { const int idx = tid + 512 * cc, row = idx >> 5, ch = idx & 31; st16(QD + (row * 264 + ch * 8) * 2, pq[cc]); st16(KI + (row * 264 + ch * 8) * 2, pk[cc]); }
        if (tid < 256) *(LAS f32x4*)(GL + tid * 4) = pg;
        { const int nit = item + G; if (nit < 1024) G1_PREFETCH(nit); }
        if (h != hprev) { hprev = h;
#pragma unroll
            for (int r = 0; r < 16; ++r) wf[r] = wfg[r * 1024 + h * 256 + d] * LOG2E;
            bias = bfg[h * 256 + d] * LOG2E; }
        __syncthreads();
        float bc[32]; float c = 0.f;
#pragma unroll
        for (int t = 0; t < 32; ++t) { const LAS float* gr = GL + (half * 32 + t) * 16; float z = bias;
#pragma unroll
            for (int r = 0; r < 16; ++r) z += gr[r] * wf[r];
            const float ls = fmaxf(-z, 0.f) + __builtin_amdgcn_logf(1.0f + __builtin_amdgcn_exp2f(-fabsf(z)));
            c -= ls * (1.0f / 16.0f); bc[t] = c; }
        TOT[half * 256 + d] = c;
        __syncthreads();
        const float tot0 = TOT[d], tot1 = TOT[256 + d]; const float blast = tot0 + tot1; const float add = half ? tot0 : 0.f;
        unsigned ke[16];
#pragma unroll
        for (int t = 0; t < 32; ++t) { const float bcv = bc[t] + add; const int row = half * 32 + t;
            const float qv = bf1(*(const LAS bf16*)(QD + (row * 264 + d) * 2)), kv = bf1(*(const LAS bf16*)(KI + (row * 264 + d) * 2));
            const float qd = qv * 0.0625f * __builtin_amdgcn_exp2f(bcv); const float ki = kv * __builtin_amdgcn_exp2f(-bcv); const float kev = kv * __builtin_amdgcn_exp2f(blast - bcv);
            *(LAS bf16*)(QD + (row * 264 + d) * 2) = (bf16)(cvtpk(qd, 0.f) & 0xffffu);
            *(LAS bf16*)(KI + (row * 264 + d) * 2) = (bf16)(cvtpk(ki, 0.f) & 0xffffu);
            if (t & 1) ke[t >> 1] |= cvtpk(0.f, kev) & 0xffff0000u; else ke[t >> 1] = cvtpk(kev, 0.f) & 0xffffu; }
        { v4u* kp = (v4u*)(KETg + (size_t)item * 16384 + d * 64 + half * 32);
#pragma unroll
          for (int j = 0; j < 4; ++j) kp[j] = (v4u){ke[4 * j], ke[4 * j + 1], ke[4 * j + 2], ke[4 * j + 3]}; }
        if (half == 0) DECg[item * 256 + d] = __builtin_amdgcn_exp2f(blast);
        __syncthreads();
#pragma unroll
        for (int cc = 0; cc < 4; ++cc) { const int idx = tid + 512 * cc, row = idx >> 5, ch = idx & 31; *(v4u*)(QDg + (size_t)item * 16384 + row * 256 + ch * 8) = *(const LAS v4u*)(QD + (row * 264 + ch * 8) * 2); }
        { const int tile = w & 3, ti = tile >> 1, si = tile & 1, kh = w >> 2;
          f32x16 acc = {};
          const ldsp ap = KI + ((32 * si + pi32(r32)) * 264 + kh * 128 + 8 * hi) * 2; const ldsp bp = QD + ((32 * ti + r32) * 264 + kh * 128 + 8 * hi) * 2;
#pragma unroll
          for (int s = 0; s < 8; ++s) acc = MFMA32(ld8(ap + s * 32), ld8(bp + s * 32), acc);
          if (kh == 1) {
#pragma unroll
              for (int r = 0; r < 16; ++r) RED[(tile * 16 + r) * 64 + lane] = acc[r]; }
          __syncthreads();
          if (kh == 0) { const int t = 32 * ti + r32; unsigned pk[8];
#pragma unroll
              for (int r = 0; r < 16; r += 2) { float v0 = acc[r] + RED[(tile * 16 + r) * 64 + lane], v1 = acc[r + 1] + RED[(tile * 16 + r + 1) * 64 + lane];
                  const int s0 = 32 * si + 16 * (r >> 3) + 8 * hi + (r & 7);
                  if (s0 > t) v0 = 0.f; if (s0 + 1 > t) v1 = 0.f; pk[r >> 1] = cvtpk(v0, v1); }
              bf16* op = ATTg + (size_t)item * 4096 + t * 64 + 32 * si + 8 * hi;
              *(v4u*)op = (v4u){pk[0], pk[1], pk[2], pk[3]}; *(v4u*)(op + 16) = (v4u){pk[4], pk[5], pk[6], pk[7]}; }
        }
        __syncthreads();
    }
}

#undef G1_PREFETCH
__device__ __forceinline__ void gla_scan_phase(ldsp lds, const bf16* QDg, const bf16* KETg, const bf16* ATTg, const float* DECg, const bf16* VTg, bf16* O1, int vcu, int G, int tid) {
    asm volatile("" : "+v"(tid));
    const int lane = tid & 63, w = __builtin_amdgcn_readfirstlane(tid >> 6), r32 = lane & 31, hi = lane >> 5, i16 = lane & 15, q4 = lane >> 4;
    const ldsp QD = lds, KET = lds + 33792, ATT = lds + 70656, VT = lds + 79872, ST = lds + 89088; LAS float* DEC = (LAS float*)(lds + 122880);
    for (int item = vcu; item < 256; item += G) {
        const int bh = item >> 3, b = bh >> 2, h = bh & 3, j = item & 7;
        f32x16 st[2]; st[0] = (f32x16){}; st[1] = (f32x16){};
        __syncthreads();
        for (int u = tid; u < 33792 / 16; u += 512) st16(ST + u * 16, (v4u){0u, 0u, 0u, 0u});
        v4u rq[4], rk[4], ra, rv; f32x4 rd = {0.f, 0.f, 0.f, 0.f};
#define G2_LOAD(nn) do { const size_t cb = (size_t)(bh * 32 + (nn)); const int tok0_ = b * SEQ + (nn) * 64; \
        _Pragma("unroll") for (int cc = 0; cc < 4; ++cc) { rq[cc] = *(const v4u*)(QDg + cb * 16384 + (size_t)(tid + 512 * cc) * 8); rk[cc] = *(const v4u*)(KETg + cb * 16384 + (size_t)(tid + 512 * cc) * 8); } \
        ra = *(const v4u*)(ATTg + cb * 4096 + tid * 8); rv = *(const v4u*)(VTg + (size_t)(h * 512 + j * 64 + (tid >> 3)) * M + tok0_ + (tid & 7) * 8); \
        if (tid < 64) rd = *(const f32x4*)(DECg + cb * 256 + tid * 4); } while (0)
#define G2_STORE() do { _Pragma("unroll") for (int cc = 0; cc < 4; ++cc) { const int idx = tid + 512 * cc; st16(QD + ((idx >> 5) * 264 + (idx & 31) * 8) * 2, rq[cc]); st16(KET + ((idx >> 3) * 72 + (idx & 7) * 8) * 2, rk[cc]); } \
        st16(ATT + ((tid >> 3) * 72 + (tid & 7) * 8) * 2, ra); st16(VT + ((tid >> 3) * 72 + (tid & 7) * 8) * 2, rv); if (tid < 64) *(LAS f32x4*)(DEC + tid * 4) = rd; } while (0)
        G2_LOAD(0);
        G2_STORE();
        for (int n = 0; n < 32; ++n) {
            if (n + 1 < 32) G2_LOAD(n + 1);
            __syncthreads();
            { const int tb = w & 3, ebp = w >> 2; f32x4 a0 = {0.f, 0.f, 0.f, 0.f}, a1 = {0.f, 0.f, 0.f, 0.f};
              const ldsp bA = ATT + ((16 * tb + i16) * 72 + 8 * q4) * 2, bQ = QD + ((16 * tb + i16) * 264 + 8 * q4) * 2;
              const ldsp v0 = VT + ((32 * ebp + i16) * 72 + 8 * q4) * 2, v1 = v0 + 16 * 72 * 2;
              const ldsp s0 = ST + ((32 * ebp + i16) * 264 + 8 * q4) * 2, s1 = s0 + 16 * 264 * 2;
              bf16x8 bb[10], aa[8];
#pragma unroll
              for (int ks = 0; ks < 2; ++ks) bb[ks] = ld8(bA + ks * 64);
#pragma unroll
              for (int ks = 0; ks < 8; ++ks) bb[2 + ks] = ld8(bQ + ks * 64);
              aa[0] = ld8(v0); aa[1] = ld8(v1); aa[2] = ld8(v0 + 64); aa[3] = ld8(v1 + 64); aa[4] = ld8(s0); aa[5] = ld8(s1); aa[6] = ld8(s0 + 64); aa[7] = ld8(s1 + 64);
              __builtin_amdgcn_sched_barrier(0);
#pragma unroll
              for (int i = 0; i < 4; ++i) { a0 = MFMA16(aa[2 * i], bb[i], a0); a1 = MFMA16(aa[2 * i + 1], bb[i], a1); }
              __builtin_amdgcn_sched_barrier(0);
#pragma unroll
              for (int i = 0; i < 4; ++i) { aa[2 * i] = ld8(s0 + (2 + i) * 64); aa[2 * i + 1] = ld8(s1 + (2 + i) * 64); }
              __builtin_amdgcn_sched_barrier(0);
#pragma unroll
              for (int i = 0; i < 4; ++i) { a0 = MFMA16(aa[2 * i], bb[4 + i], a0); a1 = MFMA16(aa[2 * i + 1], bb[4 + i], a1); }
              __builtin_amdgcn_sched_barrier(0);
#pragma unroll
              for (int i = 0; i < 2; ++i) { aa[2 * i] = ld8(s0 + (6 + i) * 64); aa[2 * i + 1] = ld8(s1 + (6 + i) * 64); }
              __builtin_amdgcn_sched_barrier(0);
#pragma unroll
              for (int i = 0; i < 2; ++i) { a0 = MFMA16(aa[2 * i], bb[8 + i], a0); a1 = MFMA16(aa[2 * i + 1], bb[8 + i], a1); }
              __builtin_amdgcn_sched_barrier(0);
              bf16* op = O1 + (size_t)(b * SEQ + n * 64 + 16 * tb + i16) * D + h * 512 + j * 64 + 32 * ebp + 4 * q4;
              *(v2u*)op = (v2u){cvtpk(a0[0], a0[1]), cvtpk(a0[2], a0[3])}; *(v2u*)(op + 16) = (v2u){cvtpk(a1[0], a1[1]), cvtpk(a1[2], a1[3])}; }
            { float dc[16];
#pragma unroll
              for (int g = 0; g < 2; ++g) { const f32x4 x0 = *(const LAS f32x4*)(DEC + 32 * w + 16 * g + 8 * hi), x1 = *(const LAS f32x4*)(DEC + 32 * w + 16 * g + 8 * hi + 4);
                  dc[8 * g + 0] = x0[0]; dc[8 * g + 1] = x0[1]; dc[8 * g + 2] = x0[2]; dc[8 * g + 3] = x0[3]; dc[8 * g + 4] = x1[0]; dc[8 * g + 5] = x1[1]; dc[8 * g + 6] = x1[2]; dc[8 * g + 7] = x1[3]; }
              const ldsp ka = KET + ((32 * w + pi32(r32)) * 72 + 8 * hi) * 2; const ldsp vb0 = VT + (r32 * 72 + 8 * hi) * 2, vb1 = vb0 + 32 * 72 * 2;
              bf16x8 ka4[4], va4[4], vb4[4];
#pragma unroll
              for (int ks = 0; ks < 4; ++ks) { ka4[ks] = ld8(ka + ks * 32); va4[ks] = ld8(vb0 + ks * 32); vb4[ks] = ld8(vb1 + ks * 32); }
#pragma unroll
              for (int r = 0; r < 16; ++r) { st[0][r] *= dc[r]; st[1][r] *= dc[r]; }
              __builtin_amdgcn_sched_barrier(0);
#pragma unroll
              for (int ks = 0; ks < 4; ++ks) { st[0] = MFMA32(ka4[ks], va4[ks], st[0]); st[1] = MFMA32(ka4[ks], vb4[ks], st[1]); }
              __builtin_amdgcn_sched_barrier(0); }
            __syncthreads();
#pragma unroll
            for (int eb = 0; eb < 2; ++eb)
#pragma unroll
                for (int g = 0; g < 2; ++g) st16(ST + ((32 * eb + r32) * 264 + 32 * w + 16 * g + 8 * hi) * 2,
                    (v4u){cvtpk(st[eb][8 * g], st[eb][8 * g + 1]), cvtpk(st[eb][8 * g + 2], st[eb][8 * g + 3]), cvtpk(st[eb][8 * g + 4], st[eb][8 * g + 5]), cvtpk(st[eb][8 * g + 6], st[eb][8 * g + 7])});
            if (n + 1 < 32) G2_STORE();
        }
#undef G2_LOAD
#undef G2_STORE
    }
}

__device__ __forceinline__ void gla_gate_phase(const bf16* O1, const bf16* PROJ, const float* gn, bf16* A2, int gw, int NGW, int lane) {
    const f32x4 g0 = *(const f32x4*)(gn + lane * 8), g1 = *(const f32x4*)(gn + lane * 8 + 4);
    const float g[8] = {g0[0], g0[1], g0[2], g0[3], g1[0], g1[1], g1[2], g1[3]};
    for (int tok = gw; tok < M; tok += NGW) {
        v4u ov[4], rv[4];
#pragma unroll
        for (int h = 0; h < 4; ++h) { ov[h] = __builtin_nontemporal_load((const v4u*)(O1 + (size_t)tok * D + h * 512 + lane * 8)); rv[h] = __builtin_nontemporal_load((const v4u*)(PROJ + (size_t)tok * 4096 + 2048 + h * 512 + lane * 8)); }
#pragma unroll
        for (int h = 0; h < 4; ++h) {
            float o[8] = {bflo(ov[h].x), bfhi(ov[h].x), bflo(ov[h].y), bfhi(ov[h].y), bflo(ov[h].z), bfhi(ov[h].z), bflo(ov[h].w), bfhi(ov[h].w)};
            float r[8] = {bflo(rv[h].x), bfhi(rv[h].x), bflo(rv[h].y), bfhi(rv[h].y), bflo(rv[h].z), bfhi(rv[h].z), bflo(rv[h].w), bfhi(rv[h].w)};
            float ss = 0.f;
#pragma unroll
            for (int i = 0; i < 8; ++i) ss += o[i] * o[i];
            const float rstd = 1.0f / sqrtf(wave_sum(ss) * (1.f / 512.f) + EPS);
            float y[8];
#pragma unroll
            for (int i = 0; i < 8; ++i) y[i] = o[i] * rstd * g[i] * (r[i] * __builtin_amdgcn_rcpf(1.0f + __expf(-r[i])));
            *(v4u*)(A2 + (size_t)tok * D + h * 512 + lane * 8) = (v4u){cvtpk(y[0], y[1]), cvtpk(y[2], y[3]), cvtpk(y[4], y[5]), cvtpk(y[6], y[7])}; }
    }
}
#define XB_TMO      128
#define XB_XCNT(j)  (256  + 64 * (j))
#define XB_XSUB(j)  (1280 + 64 * (j))
#define XB_XGEN(j)  (2304 + 64 * (j))
#define XB_TOP      3328
#define XB_TOPGEN   3392
#define XCD_BAR_WORDS 3456
#define XB_SPIN_CAP (1u << 18)

__device__ __forceinline__ unsigned xb_ld(unsigned* p)              { return __hip_atomic_load(p, __ATOMIC_RELAXED, __HIP_MEMORY_SCOPE_AGENT); }
__device__ __forceinline__ unsigned xb_add(unsigned* p, unsigned v) { return __hip_atomic_fetch_add(p, v, __ATOMIC_RELAXED, __HIP_MEMORY_SCOPE_AGENT); }
__device__ __forceinline__ unsigned xb_xcc_id() { return (unsigned)__builtin_amdgcn_s_getreg((3 << 11) | 20) & 0xFu; }
#define XB_SPIN(cond, bar) do { unsigned _sp = 0; while (cond) { __builtin_amdgcn_s_sleep(1); \
    if ((++_sp & 255u) == 0u) { if (xb_ld(&(bar)[XB_TMO])) break; if (_sp > XB_SPIN_CAP) { atomicAdd(&(bar)[XB_TMO], 1u); break; } } } } while (0)

struct XcdBarrier {
    unsigned* bar; unsigned x;
    volatile LAS unsigned* st;
};

__device__ __forceinline__ XcdBarrier xcd_barrier_post(unsigned* bar, volatile LAS unsigned* st) {
    XcdBarrier b; b.bar = bar; b.x = xb_xcc_id(); b.st = st;
    if (threadIdx.x == 0) (void)xb_add(&bar[XB_XCNT(b.x)], 1u);
    return b;
}
__device__ __forceinline__ void xcd_barrier_complete(unsigned* bar, unsigned x, unsigned& nloc, unsigned& nx) {
    const unsigned G = gridDim.x * gridDim.y * gridDim.z;
    unsigned sum, cnt, mine, sp = 0u;
    for (;;) {
        sum = 0u; cnt = 0u; mine = 0u;
#pragma unroll
        for (unsigned j = 0; j < 16; ++j) { const unsigned c = xb_ld(&bar[XB_XCNT(j)]); sum += c; cnt += (c > 0u) ? 1u : 0u; mine = (j == x) ? c : mine; }
        if (sum == G) break;
        __builtin_amdgcn_s_sleep(1);
        if ((++sp & 255u) == 0u) { if (xb_ld(&bar[XB_TMO])) break; if (sp > XB_SPIN_CAP) { atomicAdd(&bar[XB_TMO], 1u); break; } }
    }
    nloc = mine > 0u ? mine : 1u; nx = cnt > 0u ? cnt : 1u;
}

__device__ __forceinline__ void xcd_barrier(const XcdBarrier& b) {
    asm volatile("s_waitcnt vmcnt(0)" ::: "memory");
    __syncthreads();
    if (threadIdx.x == 0) {
        unsigned* bar = b.bar;
        __builtin_amdgcn_s_waitcnt(0);
        unsigned nloc = b.st[0], nx = b.st[1];
        if (nloc == 0u) { xcd_barrier_complete(bar, b.x, nloc, nx); b.st[0] = nloc; b.st[1] = nx; }
        const unsigned old = xb_add(&bar[XB_XSUB(b.x)], 1u);
        const unsigned gen = old / nloc;
        if (old + 1u == (gen + 1u) * nloc) {
            __builtin_amdgcn_fence(__ATOMIC_RELEASE, "agent");
            asm volatile("s_waitcnt vmcnt(0)" ::: "memory");
            const unsigned og = xb_add(&bar[XB_TOP], 1u);
            const unsigned tg = og / nx;
            if (og + 1u == (tg + 1u) * nx) xb_add(&bar[XB_TOPGEN], 1u);
            else XB_SPIN(xb_ld(&bar[XB_TOPGEN]) == tg, bar);
            __builtin_amdgcn_fence(__ATOMIC_ACQUIRE, "agent");
            xb_add(&bar[XB_XGEN(b.x)], 1u);
            asm volatile("s_waitcnt vmcnt(0)" ::: "memory");
        } else {
            XB_SPIN(xb_ld(&bar[XB_XGEN(b.x)]) == gen, bar);
            __builtin_amdgcn_fence(__ATOMIC_ACQUIRE, "agent");
            asm volatile("s_waitcnt vmcnt(0)" ::: "memory");
        }
    }
    __syncthreads();
}

__device__ __forceinline__ void attn_phase(ldsp lds, const bf16* KQ, const bf16* VTa, const float* relb, const float* lq1, const float* lk1, const float* lq2, const float* lk2,
                                           const float* subg, bf16* O2, int vcu, int G, int tid) {
    asm volatile("" : "+v"(tid));
    const int lane = tid & 63, w = __builtin_amdgcn_readfirstlane(tid >> 6), i16 = lane & 15, g4 = lane >> 4;
    const int mh = w >> 2, qb4 = w & 3;
    constexpr int ABUF = 65536;
    LAS float* TB = (LAS float*)(lds + 2 * ABUF); LAS float* LAMS = (LAS float*)(lds + 2 * ABUF + 1024); LAS float* XO = (LAS float*)lds;
    if (w == 0) { float a = lq1[lane] * lk1[lane] + lq1[lane + 64] * lk1[lane + 64], b = lq2[lane] * lk2[lane] + lq2[lane + 64] * lk2[lane + 64];
        a = wave_sum(a); b = wave_sum(b); if (lane == 0) LAMS[0] = expf(a) - expf(b) + LAMBDA_INIT; }
    const float c1 = 0.08838834764831845f * LOG2E;
    for (int v = vcu; v < 256; v += G) {
        const int h = v >> 5, cq = v & 31;
        __syncthreads();
        { int t2 = tid; asm volatile("" : "+v"(t2));
          if (t2 < 129) { int bucket; if (t2 < 16) bucket = t2; else { bucket = 16 + (int)(logf((float)t2 * (1.0f / 16.0f)) / 2.0794415416798357f * 16.0f); if (bucket > 31) bucket = 31; }
            TB[t2] = relb[bucket * 8 + h] * 11.313708498984761f; } }
        for (int ui = 0; ui < 8; ++ui) {
            const int b = ui; const int qb = (ui & 1) ? 31 - cq : cq;
            const int q0 = qb * 64; const int qrow = 16 * qb4 + i16; const size_t tokq = (size_t)b * SEQ + q0 + qrow;
            bf16x8 qf[4];
#pragma unroll
            for (int ks = 0; ks < 4; ++ks) qf[ks] = *(const bf16x8*)(KQ + tokq * 4096 + 2048 + h * 256 + mh * 128 + 32 * ks + 8 * g4);
            f32x4 o[16];
#pragma unroll
            for (int eb = 0; eb < 16; ++eb) o[eb] = (f32x4){0.f, 0.f, 0.f, 0.f};
            float mrun = -INFINITY, lrun = 0.f;
            unsigned kdo[4], vdo[4];
#pragma unroll
            for (int cc = 0; cc < 4; ++cc) { const int p = 4 * w + cc;
                const int lr = 2 * p + (lane >> 5), ch = (lane & 31) ^ (lr & 15), i_ = lr & 15, t_ = (lr >> 4) & 1, gr = (lr & ~31) + 8 * (i_ >> 2) + 4 * t_ + (i_ & 3);
                kdo[cc] = (unsigned)(gr * 4096 + ch * 8);
                const int le = 8 * p + (lane >> 3), cv = (lane & 7) ^ ((le >> 1) & 7), iv = le & 15, tv = (le >> 4) & 1, ge = (le & ~31) + 8 * (iv >> 2) + 4 * tv + (iv & 3);
                vdo[cc] = (unsigned)(ge * M + cv * 8); }
#define AT_DMA(kt_, bs_) do { const bf16* kb_ = KQ + ((size_t)b * SEQ + 64 * (kt_)) * 4096 + h * 256; const bf16* vb_ = VTa + (size_t)(h * 256) * M + (size_t)b * SEQ + 64 * (kt_); \
            _Pragma("unroll") for (int cc = 0; cc < 4; ++cc) { \
                __builtin_amdgcn_global_load_lds((const unsigned*)(kb_ + kdo[cc]), (LAS unsigned*)(lds + (bs_) * ABUF + (4 * w + cc) * 1024), 16, 0, 0); \
                __builtin_amdgcn_global_load_lds((const unsigned*)(vb_ + vdo[cc]), (LAS unsigned*)(lds + (bs_) * ABUF + 32768 + (4 * w + cc) * 1024), 16, 0, 0); } } while (0)
            __syncthreads();
            AT_DMA(0, 0);
            asm volatile("s_waitcnt vmcnt(0)" : "+v"(qf[0]), "+v"(qf[1]), "+v"(qf[2]), "+v"(qf[3]) :: "memory");
            for (int kt = 0; kt <= qb; ++kt) {
                asm volatile("s_waitcnt vmcnt(0)" ::: "memory"); __syncthreads();
                if (kt + 1 <= qb) AT_DMA(kt + 1, (kt + 1) & 1);
                const ldsp Kb = lds + (kt & 1) * ABUF + i16 * 512 + mh * 256, Vb = lds + (kt & 1) * ABUF + 32768 + i16 * 128;
                const int kx = g4 ^ i16, vx = g4 ^ (i16 >> 1);
                const ldsp kbs0 = Kb + kx * 16, kbs1 = Kb + (kx ^ 4) * 16, kbs2 = Kb + (kx ^ 8) * 16, kbs3 = Kb + (kx ^ 12) * 16, vbs0 = Vb + vx * 16, vbs1 = Vb + (vx ^ 4) * 16;
                const int k0 = 64 * kt;
#define SB() __builtin_amdgcn_sched_barrier(0)
#define LDK(dst, hf_, bt_) do { _Pragma("unroll") for (int j_ = 0; j_ < 2; ++j_) _Pragma("unroll") for (int t_ = 0; t_ < 2; ++t_) dst[2 * j_ + t_] = ld8(((2 * (bt_) + j_) == 0 ? kbs0 : (2 * (bt_) + j_) == 1 ? kbs1 : (2 * (bt_) + j_) == 2 ? kbs2 : kbs3) + (32 * (hf_) + 16 * t_) * 512); } while (0)
#define LDV(dst, hf_, bt_) do { _Pragma("unroll") for (int j_ = 0; j_ < 4; ++j_) dst[j_] = ld8(((hf_) == 0 ? vbs0 : vbs1) + (4 * (bt_) + j_) * 16 * 128); } while (0)
#define MMK(src, bt_) do { s[0] = MFMA16(src[0], qf[2 * (bt_)], s[0]); s[1] = MFMA16(src[1], qf[2 * (bt_)], s[1]); s[0] = MFMA16(src[2], qf[2 * (bt_) + 1], s[0]); s[1] = MFMA16(src[3], qf[2 * (bt_) + 1], s[1]); } while (0)
#define MMV(src, bt_) do { _Pragma("unroll") for (int j_ = 0; j_ < 4; ++j_) o[4 * (bt_) + j_] = MFMA16(src[j_], pb, o[4 * (bt_) + j_]); } while (0)
                bf16x8 X[4], Y[4];
                LDK(X, 0, 0); SB();
#pragma unroll
                for (int hf = 0; hf < 2; ++hf) {
                    f32x4 s[2];
                    const int dbase = q0 + qrow - k0 - 32 * hf - 8 * g4;
                    if (q0 - k0 - 32 * hf - 31 >= 128) { const float cb = TB[128]; s[0] = (f32x4){cb, cb, cb, cb}; s[1] = s[0]; }
                    else {
#pragma unroll
                        for (int t = 0; t < 2; ++t)
#pragma unroll
                            for (int r = 0; r < 4; ++r) { const int d0 = dbase - 4 * t - r; const float b0 = TB[min(max(d0, 0), 128)]; s[t][r] = d0 < 0 ? -INFINITY : b0; }
                    }
                    SB(); LDK(Y, hf, 1); SB();
                    MMK(X, 0); SB();
                    LDV(X, hf, 0); SB();
                    MMK(Y, 1); SB();
                    float mx = fmaxf(fmaxf(fmaxf(s[0][0], s[0][1]), fmaxf(s[0][2], s[0][3])), fmaxf(fmaxf(s[1][0], s[1][1]), fmaxf(s[1][2], s[1][3]))) * c1;
                    if (__any(mx > mrun + 8.0f)) {
                        { auto r1 = __builtin_amdgcn_permlane16_swap(__float_as_uint(mx), __float_as_uint(mx), false, false); mx = fmaxf(__uint_as_float(r1[0]), __uint_as_float(r1[1]));
                          auto r2 = __builtin_amdgcn_permlane32_swap(__float_as_uint(mx), __float_as_uint(mx), false, false); mx = fmaxf(__uint_as_float(r2[0]), __uint_as_float(r2[1])); }
                        const float mnew = fmaxf(mrun, mx); const float alpha = __builtin_amdgcn_exp2f(mrun - mnew); mrun = mnew; lrun *= alpha;
#pragma unroll
                        for (int eb = 0; eb < 16; ++eb) o[eb] = o[eb] * alpha; }
                    float p[8];
#pragma unroll
                    for (int t = 0; t < 2; ++t)
#pragma unroll
                        for (int r = 0; r < 4; ++r) p[4 * t + r] = __builtin_amdgcn_exp2f(s[t][r] * c1 - mrun);
                    lrun += ((p[0] + p[1]) + (p[2] + p[3])) + ((p[4] + p[5]) + (p[6] + p[7]));
                    v4u pk = {cvtpk(p[0], p[1]), cvtpk(p[2], p[3]), cvtpk(p[4], p[5]), cvtpk(p[6], p[7])}; const bf16x8 pb = __builtin_bit_cast(bf16x8, pk);
                    SB(); LDV(Y, hf, 1); SB();
                    MMV(X, 0); SB();
                    LDV(X, hf, 2); SB();
                    MMV(Y, 1); SB();
                    LDV(Y, hf, 3); SB();
                    MMV(X, 2); SB();
                    if (hf == 0) { LDK(X, 1, 0); SB(); }
                    MMV(Y, 3); SB();
                }
#undef LDK
#undef LDV
#undef MMK
#undef MMV
            }
#undef AT_DMA
            float lsum = lrun + __shfl_xor(lrun, 16); lsum += __shfl_xor(lsum, 32); const float inv = 1.0f / lsum;
            int lz = lane; asm volatile("" : "+v"(lz)); const int gz = lz >> 4, iz = lz & 15;
            __syncthreads();
            if (mh == 1) {
#pragma unroll
                for (int eb = 0; eb < 16; ++eb)
#pragma unroll
                    for (int r = 0; r < 4; ++r) XO[(((w - 4) * 64) + eb * 4 + r) * 64 + lz] = o[eb][r] * inv; }
            __syncthreads();
            if (mh == 0) { const float lam = LAMS[0]; float ss = 0.f;
#pragma unroll
                for (int eb = 0; eb < 16; ++eb)
#pragma unroll
                    for (int r = 0; r < 4; ++r) { const float vv = o[eb][r] * inv - lam * XO[((w * 64) + eb * 4 + r) * 64 + lz]; o[eb][r] = vv; ss += vv * vv; }
                ss += __shfl_xor(ss, 16); ss += __shfl_xor(ss, 32);
                const float rstd = (1.0f - LAMBDA_INIT) / sqrtf(ss * (1.f / 256.f) + EPS);
                bf16* op = O2 + ((size_t)b * SEQ + q0 + 16 * qb4 + iz) * D + h * 256 + 8 * gz;
#pragma unroll
                for (int pp = 0; pp < 8; ++pp) { const int e = 32 * pp + 8 * gz; const f32x4 g0 = *(const f32x4*)(subg + e), g1 = *(const f32x4*)(subg + e + 4);
                    v4u ov; ov.x = cvtpk(o[2 * pp][0] * rstd * g0[0], o[2 * pp][1] * rstd * g0[1]); ov.y = cvtpk(o[2 * pp][2] * rstd * g0[2], o[2 * pp][3] * rstd * g0[3]);
                    ov.z = cvtpk(o[2 * pp + 1][0] * rstd * g1[0], o[2 * pp + 1][1] * rstd * g1[1]); ov.w = cvtpk(o[2 * pp + 1][2] * rstd * g1[2], o[2 * pp + 1][3] * rstd * g1[3]);
                    *(v4u*)(op + 32 * pp) = ov; } }
        }
    }
}

struct Args { const float* in[22]; float* out; unsigned char* ws; };
__global__ void __launch_bounds__(NWAVES * 64, 2) yoco_fwd(Args args) {
    extern __shared__ __attribute__((aligned(16))) unsigned char lds_raw[];
    cg::grid_group grid = cg::this_grid();
    const ldsp lds = (ldsp)lds_raw;
    const int tid = threadIdx.x, lane = tid & 63, wave = __builtin_amdgcn_readfirstlane(tid >> 6);
    const int G = gridDim.x, bx = blockIdx.x; const int vcu = (G % 8 == 0) ? (bx % 8) * (G / 8) + bx / 8 : bx;
    const int gw = vcu * NWAVES + wave, NGW = G * NWAVES;
    unsigned char* ws = args.ws;
    const float* x = args.in[0]; const float* relb = args.in[1]; const float* kv_g = args.in[2]; const float* w_kv = args.in[3]; const float* w_in = args.in[4];
    const float* w_fg = args.in[5]; const float* b_fg = args.in[6]; const float* gla_ng = args.in[7]; const float* gla_wout = args.in[8]; const float* w_q = args.in[9];
    const float* lq1 = args.in[10]; const float* lk1 = args.in[11]; const float* lq2 = args.in[12]; const float* lk2 = args.in[13]; const float* subg = args.in[14];
    const float* diff_wout = args.in[15]; const float* pre_mix = args.in[16]; const float* post_mix = args.in[17]; const float* pre_ffn = args.in[18]; const float* post_ffn = args.in[19];
    const float* w_gu = args.in[20]; const float* w_dn = args.in[21];
    float* out = args.out;
    bf16* WG = (bf16*)(ws + WS_WG); bf16* WINA = (bf16*)(ws + WS_WINA); bf16* WINV = (bf16*)(ws + WS_WINV); bf16* WOUTA = (bf16*)(ws + WS_WOUTA);
    bf16* WGU0 = (bf16*)(ws + WS_WGU0); bf16* WGU1 = (bf16*)(ws + WS_WGU1); bf16* WDN0 = (bf16*)(ws + WS_WDN0); bf16* WDN1 = (bf16*)(ws + WS_WDN1);
    bf16* WKQ = (bf16*)(ws + WS_WKQ); bf16* WV = (bf16*)(ws + WS_WV); bf16* WOUTB = (bf16*)(ws + WS_WOUTB);
    bf16* BUFA = (bf16*)(ws + WS_BUFA); bf16* XN0 = (bf16*)(ws + WS_XN0); float* SQ0 = (float*)(ws + WS_SQ0); bf16* BUFB = (bf16*)(ws + WS_BUFB); float* GLR = (float*)(ws + WS_GLR); float* DECg = (float*)(ws + WS_DEC); bf16* ATTg = (bf16*)(ws + WS_ATT);
    bf16* PROJ = (bf16*)(ws + WS_R1); bf16* VTg = (bf16*)(ws + WS_VT); bf16* QDg = (bf16*)(ws + WS_QD); bf16* KETg = (bf16*)(ws + WS_KET); bf16* ACT = (bf16*)(ws + WS_R1); float* RS = (float*)(ws + WS_RS); bf16* O2B = (bf16*)(ws + WS_QD);

    for (int u = tid; u < 16; u += NWAVES * 64) ((LAS unsigned*)(lds + MISC_OFF))[u] = 0u;
    __syncthreads();
    XcdBarrier xbar = xcd_barrier_post((unsigned*)(ws + WS_CTL) + 1024, (volatile LAS unsigned*)(lds + MISC_OFF));
#define GSYNC() xcd_barrier(xbar)
    {
        LAS float* scr = (LAS float*)(lds + wave * 17408);
        constexpr int NITEMS = (2048 / 64) * ((8 * 2048) / 64) + 2 * (2048 / 64) * (11264 / 64) + 2 * (5632 / 64) * (2048 / 64);
#define SEG(W_, ldw_, col0_, K_, ncols_, gain_, dst_, mode_) if (!found_) { const int nblk_ = (ncols_) / 64, cnt_ = ((K_) / 64) * nblk_; if (r_ < cnt_) { const int kb_ = r_ / nblk_, nb_ = r_ % nblk_; \
            const float* gp_ = (gain_); dref_.src = (W_) + (size_t)(64 * kb_) * (ldw_) + (col0_) + 64 * nb_; dref_.gain = gp_ ? gp_ + 64 * kb_ : nullptr; dref_.dst = (dst_) + 64 * kb_; dref_.ldw = (ldw_); dref_.K = (K_); dref_.mode = (mode_); dref_.n0 = 64 * nb_; found_ = true; } else r_ -= cnt_; }
#define P0_DECODE(it_, dd_) do { int r_ = (it_); bool found_ = false; P0Desc& dref_ = (dd_); \
            SEG(w_gu, 11264, 0, 2048, 11264, pre_ffn, WGU0, 1) \
            SEG(w_gu + (size_t)2048 * 11264, 11264, 0, 2048, 11264, pre_ffn + D, WGU1, 1) \
            SEG(w_dn, 2048, 0, 5632, 2048, (const float*)nullptr, WDN0, 0) \
            SEG(w_dn + (size_t)5632 * 2048, 2048, 0, 5632, 2048, (const float*)nullptr, WDN1, 0) \
            SEG(w_in, GLA_IN, 0, 2048, 2048, pre_mix, WINA, 0) \
            SEG(w_in, GLA_IN, 4096, 2048, 2048, pre_mix, WINA + (size_t)2048 * 2048, 0) \
            SEG(w_in, GLA_IN, 2048, 2048, 2048, pre_mix, WINV, 0) \
            SEG(gla_wout, 2048, 0, 2048, 2048, (const float*)nullptr, WOUTA, 0) \
            SEG(w_kv, 4096, 0, 2048, 2048, kv_g, WKQ, 0) \
            SEG(w_kv, 4096, 2048, 2048, 2048, kv_g, WV, 0) \
            SEG(w_q, 2048, 0, 2048, 2048, pre_mix + D, WKQ + (size_t)2048 * 2048, 0) \
            SEG(diff_wout, 2048, 0, 2048, 2048, (const float*)nullptr, WOUTB, 0) } while (0)
        if (gw < NITEMS) {
            int it = gw; P0Desc cur, nxt; f32x4 R[16];
            P0_DECODE(it, cur); p0_load(cur, R, lane);
            for (;;) {
                p0_to_lds(R, scr, lane);
                const int nit = it + NGW; const bool more = nit < NITEMS;
                if (more) { P0_DECODE(nit, nxt); p0_load(nxt, R, lane); }
                asm volatile("s_waitcnt lgkmcnt(0)" ::: "memory");
                p0_emit(cur, scr, lane);
                asm volatile("s_waitcnt lgkmcnt(0)" ::: "memory");
                if (!more) break;
                cur = nxt; it = nit;
            }
        }
#undef SEG
#undef P0_DECODE
        for (int e = gw * 64 + lane; e < 16 * 2048; e += NGW * 64) { const int r = e >> 11, k = e & 2047; WG[e] = (bf16)(cvtpk(pre_mix[k] * w_in[(size_t)k * GLA_IN + 6144 + r], 0.f) & 0xffffu); }
        for (int m = 2 * gw; m < M; m += 2 * NGW) {
            const f32x4* xr0 = (const f32x4*)(x + (size_t)m * D) + lane; const f32x4* xr1 = xr0 + D / 4;
            f32x4 v0[8], v1[8]; float s0 = 0.f, s1 = 0.f;
#pragma unroll
            for (int j = 0; j < 8; ++j) v0[j] = __builtin_nontemporal_load(xr0 + 64 * j);
#pragma unroll
            for (int j = 0; j < 8; ++j) v1[j] = __builtin_nontemporal_load(xr1 + 64 * j);
#pragma unroll
            for (int j = 0; j < 8; ++j) { s0 += (v0[j].x * v0[j].x + v0[j].y * v0[j].y) + (v0[j].z * v0[j].z + v0[j].w * v0[j].w); s1 += (v1[j].x * v1[j].x + v1[j].y * v1[j].y) + (v1[j].z * v1[j].z + v1[j].w * v1[j].w); }
            const float r0 = 1.0f / sqrtf(wave_sum(s0) * (1.f / D) + EPS), r1 = 1.0f / sqrtf(wave_sum(s1) * (1.f / D) + EPS);
            v2u* o0 = (v2u*)(XN0 + (size_t)m * D) + lane; v2u* o1 = o0 + D / 4;
            if (lane == 0) { SQ0[m] = 1.0f / r0; SQ0[m + 1] = 1.0f / r1; }
#pragma unroll
            for (int j = 0; j < 8; ++j) { v2u w; w.x = cvtpk(v0[j].x * r0, v0[j].y * r0); w.y = cvtpk(v0[j].z * r0, v0[j].w * r0); o0[64 * j] = w; }
#pragma unroll
            for (int j = 0; j < 8; ++j) { v2u w; w.x = cvtpk(v1[j].x * r1, v1[j].y * r1); w.y = cvtpk(v1[j].z * r1, v1[j].w * r1); o1[64 * j] = w; }
        }
    }
    if (gridDim.y == 4242u) grid.sync();
    GSYNC();
    {
        glr_phase(lds, XN0, WG, GLR, G, tid);
        { pg8::Gemm g{XN0, WINA, M, 4096, D}; pg8::StaticOrder S; S.init(M, 4096, G, bx); pg8::EpiBf16<0> E{PROJ, 4096, nullptr, 0, 0, 1.f};
          pg8::gemm_phase<pg8::EpiBf16<0>, pg8::StaticOrder, true, true>(lds, g, S, E); }
        { pg8::Gemm g{WINV, XN0, 2048, M, D}; pg8::StaticOrder S; S.init(2048, M, G, bx); pg8::EpiBf16<0> E{VTg, M, nullptr, 0, 0, 1.f};
          pg8::gemm_phase<pg8::EpiBf16<0>, pg8::StaticOrder, true, true>(lds, g, S, E); }
    }
    GSYNC();
#ifndef SKIP_G1
    gla_pre_phase(lds, PROJ, GLR, w_fg, b_fg, QDg, KETg, ATTg, DECg, vcu, G, tid);
#endif
    GSYNC();
#ifndef SKIP_G2
    gla_scan_phase(lds, QDg, KETg, ATTg, DECg, VTg, BUFB, vcu, G, tid);
#endif
    GSYNC();
    gla_gate_phase(BUFB, PROJ, gla_ng, BUFA, gw, NGW, lane);
    GSYNC();
    { pg8::Gemm g{BUFA, WOUTA, M, D, D}; pg8::StaticOrder S; S.init(M, D, G, bx); pg8::EpiBf16<0> E{BUFB, D, nullptr, 0, 0, 1.f};
      pg8::gemm_phase<pg8::EpiBf16<0>, pg8::StaticOrder, true, true>(lds, g, S, E); }
    GSYNC();
    norm_res_phase<false, false>(XN0, BUFB, post_mix, BUFA, RS, SQ0, gw, NGW, lane);
    GSYNC();
    { pg8::Gemm g{BUFA, WGU0, M, 2 * DFF, D}; pg8::StaticOrder S; S.init(M, 2 * DFF, G, bx); pg8::EpiSwiglu E{ACT, DFF, RS};
      pg8::gemm_phase<pg8::EpiSwiglu, pg8::StaticOrder, true, true>(lds, g, S, E); }
    GSYNC();
    { pg8::Gemm g{ACT, WDN0, M, D, DFF}; pg8::StaticOrder S; S.init(M, D, G, bx); pg8::EpiBf16<0> E{BUFB, D, nullptr, 0, 0, 1.f};
      pg8::gemm_phase<pg8::EpiBf16<0>, pg8::StaticOrder, true, true>(lds, g, S, E); }
    GSYNC();
    norm_res_phase<false, false>(BUFA, BUFB, post_ffn, BUFA, RS, nullptr, gw, NGW, lane);
    GSYNC();
    {
        { pg8::Gemm g{BUFA, WKQ, M, 4096, D}; pg8::StaticOrder S; S.init(M, 4096, G, bx); pg8::EpiBf16S E{PROJ, 4096, RS, nullptr};
          pg8::gemm_phase<pg8::EpiBf16S, pg8::StaticOrder, true, true>(lds, g, S, E); }
        { pg8::Gemm g{WV, BUFA, 2048, M, D}; pg8::StaticOrder S; S.init(2048, M, G, bx); pg8::EpiBf16S E{VTg, M, nullptr, RS};
          pg8::gemm_phase<pg8::EpiBf16S, pg8::StaticOrder, true, true>(lds, g, S, E); }
    }
    GSYNC();
#ifndef SKIP_AT
    attn_phase(lds, PROJ, VTg, relb, lq1, lk1, lq2, lk2, subg, O2B, vcu, G, tid);
#endif
    GSYNC();
    { pg8::Gemm g{O2B, WOUTB, M, D, D}; pg8::StaticOrder S; S.init(M, D, G, bx); pg8::EpiBf16<0> E{BUFB, D, nullptr, 0, 0, 1.f};
      pg8::gemm_phase<pg8::EpiBf16<0>, pg8::StaticOrder, true, true>(lds, g, S, E); }
    GSYNC();
    norm_res_phase<false, false>(BUFA, BUFB, post_mix + D, BUFA, RS, nullptr, gw, NGW, lane);
    GSYNC();
    { pg8::Gemm g{BUFA, WGU1, M, 2 * DFF, D}; pg8::StaticOrder S; S.init(M, 2 * DFF, G, bx); pg8::EpiSwiglu E{ACT, DFF, RS};
      pg8::gemm_phase<pg8::EpiSwiglu, pg8::StaticOrder, true, true>(lds, g, S, E); }
    GSYNC();
    { pg8::Gemm g{ACT, WDN1, M, D, DFF}; pg8::StaticOrder S; S.init(M, D, G, bx); pg8::EpiBf16<0> E{BUFB, D, nullptr, 0, 0, 1.f};
      pg8::gemm_phase<pg8::EpiBf16<0>, pg8::StaticOrder, true, true>(lds, g, S, E); }
    GSYNC();
    norm_res_phase<false, true>(BUFA, BUFB, post_ffn + D, out, nullptr, nullptr, gw, NGW, lane);
}

extern "C" void kernel_launch(void* const* d_in, const int* in_sizes, int n_in, void* d_out, int out_size, void* d_ws, size_t ws_size, hipStream_t stream) {
    static int grid = 0;
    if (grid == 0) {
        if (n_in != 22 || out_size != M * D || ws_size < WS_END) { fprintf(stderr, "kernel_launch: unexpected shapes (n_in %d out %d ws %zu need %zu)\n", n_in, out_size, ws_size, (size_t)WS_END); grid = -1; return; }
        int dev = 0, cus = 0, per_cu = 0;
        hipGetDevice(&dev); hipDeviceGetAttribute(&cus, hipDeviceAttributeMultiprocessorCount, dev);
        hipFuncSetAttribute((const void*)yoco_fwd, hipFuncAttributeMaxDynamicSharedMemorySize, LDS_BYTES);
        hipOccupancyMaxActiveBlocksPerMultiprocessor(&per_cu, (const void*)yoco_fwd, NWAVES * 64, LDS_BYTES);
        if (per_cu < 1) per_cu = 1;
        (void)hipGetLastError();
        grid = cus;
    }
    if (grid < 0) return;
    Args a{};
    for (int i = 0; i < 22; ++i) a.in[i] = (const float*)d_in[i];
    a.out = (float*)d_out; a.ws = (unsigned char*)d_ws;
    if (hipMemsetAsync((char*)d_ws + WS_CTL, 0, 65536, stream) != hipSuccess) { fprintf(stderr, "memset failed\n"); return; }
    void* kargs[] = {&a};
    hipError_t e = hipLaunchCooperativeKernel((const void*)yoco_fwd, dim3(grid), dim3(NWAVES * 64), kargs, LDS_BYTES, stream);
    if (e != hipSuccess) fprintf(stderr, "cooperative launch failed: %s (grid %d)\n", hipGetErrorString(e), grid);
}
```

```cpp
#include <hip/hip_runtime.h>
#include <hip/hip_cooperative_groups.h>
#include <cstdio>
#include <cstdint>
#include <cmath>
namespace cg = cooperative_groups;
namespace pg8 {
#define PG8_LAS __attribute__((address_space(3)))
typedef unsigned short bf16_t;
typedef short bf16x8 __attribute__((ext_vector_type(8)));
typedef float f32x4 __attribute__((ext_vector_type(4)));
typedef unsigned u32x4 __attribute__((ext_vector_type(4)));
constexpr int BM = 256, BK = 64, HALF = 128, HTB = HALF * BK * 2  , STAGE_BYTES = 8 * HTB, NXCD = 8, WGM = 8;

__host__ __device__ __forceinline__ int lds_byte(int r, int c) { const int st = (r >> 4) * 2 + (c >> 5), rr = r & 15, cc = c & 31, ob = rr * 64 + cc * 2; return st * 1024 + (ob ^ (((ob >> 9) & 1) << 5)); }
__host__ __device__ __forceinline__ void stage_rc(int b, int& R, int& C) { const int st = b / 1024, sb = b % 1024, swz = sb ^ (((sb >> 9) & 1) << 5); R = (st >> 1) * 16 + swz / 64; C = (st & 1) * 32 + (swz % 64) / 2; }
__host__ __device__ __forceinline__ int perm32(int rho) { const int n = rho >> 4, i = rho & 15; return 8 * (i >> 2) + 4 * n + (i & 3); }

struct Unit { int pm, pn; };
struct Gemm { const bf16_t* A; const bf16_t* Bt; int M, N, K; };

struct StaticOrder {
    int nM, nN, nwg, G, c;
    __host__ __device__ void init(int M, int N, int G_, int c_) { nM = M / BM; nN = N / BM; nwg = nM * nN; G = G_; c = c_; }
    __host__ __device__ bool next(int i, Unit& u) const {
        const long L = (long)i * G + c; if (L >= nwg) return false;
        int wgid = (int)L; { const int q = nwg / NXCD, r = nwg % NXCD, xcd = wgid % NXCD, off = wgid / NXCD; wgid = (xcd < r ? xcd * (q + 1) : r * (q + 1) + (xcd - r) * q) + off; }
        const int nig = WGM * nN, gid = wgid / nig, fm = gid * WGM, gsz = (nM - fm) < WGM ? (nM - fm) : WGM;
        u.pm = fm + ((wgid % nig) % gsz); u.pn = (wgid % nig) / gsz; return true;
    }
    __device__ __forceinline__ void a_ready(const Unit&) const {}
    __device__ __forceinline__ void done(const Unit&) const {}
};

__device__ __forceinline__ unsigned cvt_pk_bf16(float lo, float hi) { unsigned r; asm volatile("v_cvt_pk_bf16_f32 %0, %1, %2" : "=v"(r) : "v"(lo), "v"(hi)); return r; }
typedef float f32x2 __attribute__((ext_vector_type(2)));
__device__ __forceinline__ f32x2 gelu_pk(f32x2 v) {
    const f32x2 av = __builtin_elementwise_abs(v), d = av * 0.2316418882f + 1.0f;
    f32x2 t; t.x = __builtin_amdgcn_rcpf(d.x); t.y = __builtin_amdgcn_rcpf(d.y);
    f32x2 q = t * 0.5307027145f + (-0.7265760135f); q = q * t + 0.7107068705f; q = q * t + (-0.142248368f); q = q * t + 0.127414796f; q = q * t;
    const f32x2 s = (v * v) * (-0.72134752044f);
    f32x2 e; e.x = __builtin_amdgcn_exp2f(s.x); e.y = __builtin_amdgcn_exp2f(s.y);
    const f32x2 m = v * (q * e), r = v - m;
    f32x2 o; o.x = v.x < 0.f ? m.x : r.x; o.y = v.y < 0.f ? m.y : r.y; return o;
}

template <int ACT  > struct EpiBf16 {
    static constexpr bool PERM = true, AFTER_DRAIN = false; static_assert(ACT == 0 || ACT == 1, "EpiBf16: ACT is 0 (none) or 1 (gelu_pk)");
    bf16_t* O; int ldc; const float* bias; int split_cols; size_t split_stride; float scale0;
    __device__ __forceinline__ void operator()(const f32x4 (&acc)[2][2][4][2], const Unit& u, int wr, int wc, int fr, int fq) const {
        const int row0 = u.pm * BM + wr * 64 + fr; int colt = u.pn * BM; bf16_t* base = O;
        float sc = 1.f; if (split_cols) { const int t = colt / split_cols; base += (size_t)t * split_stride; colt -= t * split_cols; if (t == 0) sc = scale0; }
        const int col0 = colt + wc * 32 + 8 * fq, bcol0 = u.pn * BM + wc * 32 + 8 * fq;
        f32x4 bv[2][2];
#pragma unroll
        for (int bj = 0; bj < 2; ++bj)
#pragma unroll
            for (int n = 0; n < 2; ++n) bv[bj][n] = bias ? *(const f32x4*)(bias + bcol0 + bj * HALF + 4 * n) : (f32x4){0.f, 0.f, 0.f, 0.f};
#pragma unroll
        for (int ai = 0; ai < 2; ++ai)
#pragma unroll
            for (int m = 0; m < 4; ++m) { bf16_t* rowp = base + (size_t)(row0 + ai * HALF + m * 16) * ldc + col0;
#pragma unroll
                for (int bj = 0; bj < 2; ++bj) { f32x4 v0 = acc[ai][bj][m][0] + bv[bj][0], v1 = acc[ai][bj][m][1] + bv[bj][1];
                    if (ACT == 1) { f32x2 a = gelu_pk((f32x2){v0[0], v0[1]}), b = gelu_pk((f32x2){v0[2], v0[3]}), c = gelu_pk((f32x2){v1[0], v1[1]}), d = gelu_pk((f32x2){v1[2], v1[3]});
                        v0 = (f32x4){a.x, a.y, b.x, b.y}; v1 = (f32x4){c.x, c.y, d.x, d.y}; }
                    v0 = v0 * sc; v1 = v1 * sc; u32x4 w; w.x = cvt_pk_bf16(v0[0], v0[1]); w.y = cvt_pk_bf16(v0[2], v0[3]); w.z = cvt_pk_bf16(v1[0], v1[1]); w.w = cvt_pk_bf16(v1[2], v1[3]);
                    *(u32x4*)(rowp + bj * HALF) = w; } }
    }
};
template <class Epi, class Sched, bool ALIGN_EPI = false, bool SP2 = false>
__device__ __forceinline__ void gemm_phase(PG8_LAS unsigned char* lds, const Gemm g, const Sched& S, const Epi& E) {
    const int tid = threadIdx.x, wid = __builtin_amdgcn_readfirstlane(tid >> 6), lane = tid & 63, wr = wid >> 2, wc = wid & 3, fr = lane & 15, fq = lane >> 4;
    const int K = g.K, nt = K / BK;
    unsigned voffA[2], voffB[2];
#pragma unroll
    for (int i = 0; i < 2; ++i) { int R, C; stage_rc(tid * 16 + i * 8192, R, C); const int Rb = Epi::PERM ? ((R & ~31) + perm32(R & 31)) : R;
        voffA[i] = (unsigned)(R * K + C) * 2u; voffB[i] = (unsigned)(Rb * K + C) * 2u; }
    const size_t kstep = (size_t)(BK * 2);
    const size_t hstep = (size_t)HALF * K * 2;
    const size_t tstep = 2 * hstep;
    const unsigned ldsw = (unsigned)wid * 1024u;
    const int aoff = lds_byte(wr * 64 + fr, fq * 8), boff = lds_byte(wc * 32 + fr, fq * 8);
#define PG8_SA(b, h) (((b) * 2 + (h)) * HTB)
#define PG8_SB(b, h) ((4 + (b) * 2 + (h)) * HTB)
#define PG8_STAGE(bufoff, gbase, voff) do { _Pragma("unroll") for (int _i = 0; _i < 2; ++_i) \
        __builtin_amdgcn_global_load_lds((const unsigned*)((const char*)(gbase) + (voff)[_i]), (PG8_LAS unsigned*)(lds + (bufoff) + ldsw + _i * 8192), 16, 0, 0); } while (0)
#define PG8_LDA(dst, b, h) do { _Pragma("unroll") for (int m = 0; m < 4; ++m) _Pragma("unroll") for (int k = 0; k < 2; ++k) dst[m][k] = *(const PG8_LAS bf16x8*)(lds + PG8_SA(b, h) + aoff + m * 2048 + k * 1024); } while (0)
#define PG8_LDB(dst, b, h) do { _Pragma("unroll") for (int n = 0; n < 2; ++n) _Pragma("unroll") for (int k = 0; k < 2; ++k) dst[n][k] = *(const PG8_LAS bf16x8*)(lds + PG8_SB(b, h) + boff + n * 2048 + k * 1024); } while (0)
#define PG8_MMA(ai, bj, At, Bt) do { __builtin_amdgcn_s_setprio(1); _Pragma("unroll") for (int m = 0; m < 4; ++m) _Pragma("unroll") for (int n = 0; n < 2; ++n) _Pragma("unroll") for (int k = 0; k < 2; ++k) \
        acc[ai][bj][m][n] = __builtin_amdgcn_mfma_f32_16x16x32_bf16(Bt[n][k], At[m][k], acc[ai][bj][m][n], 0, 0, 0); __builtin_amdgcn_s_setprio(0); } while (0)
#define PG8_WAIT_V(n) asm volatile("s_waitcnt vmcnt(" #n ")" ::: "memory")
#define PG8_WAIT_L(n) asm volatile("s_waitcnt lgkmcnt(" #n ")" ::: "memory")
#define PG8_BAR __builtin_amdgcn_s_barrier()
#define PG8_SCHED __builtin_amdgcn_sched_barrier(0)
    Unit cur, nxt; int ui = 0;
    if (!S.next(0, cur)) return;
    f32x4 acc[2][2][4][2];
#pragma unroll
    for (int a = 0; a < 2; ++a)
#pragma unroll
        for (int b = 0; b < 2; ++b)
#pragma unroll
            for (int m = 0; m < 4; ++m)
#pragma unroll
                for (int n = 0; n < 2; ++n) acc[a][b][m][n] = (f32x4){0.f, 0.f, 0.f, 0.f};
    bf16x8 At[4][2], B0[2][2], B1[2][2];
    const char* cA = (const char*)g.A + (size_t)cur.pm * tstep; const char* cB = (const char*)g.Bt + (size_t)cur.pn * tstep;
    S.a_ready(cur);
    if constexpr (SP2) {
        PG8_STAGE(PG8_SB(0, 0), cB, voffB); PG8_STAGE(PG8_SB(0, 1), cB + hstep, voffB); PG8_STAGE(PG8_SA(0, 0), cA, voffA); PG8_STAGE(PG8_SA(0, 1), cA + hstep, voffA);
        if (wr == 1) PG8_BAR;
        PG8_WAIT_V(2); PG8_BAR;
        PG8_STAGE(PG8_SB(1, 0), cB + kstep, voffB); PG8_STAGE(PG8_SA(1, 0), cA + kstep, voffA); PG8_STAGE(PG8_SB(1, 1), cB + hstep + kstep, voffB);
        PG8_WAIT_V(6); PG8_BAR;
    } else {
        PG8_STAGE(PG8_SB(0, 0), cB, voffB); PG8_STAGE(PG8_SA(0, 0), cA, voffA); PG8_STAGE(PG8_SB(0, 1), cB + hstep, voffB); PG8_STAGE(PG8_SA(0, 1), cA + hstep, voffA);
        if (wr == 1) PG8_BAR;
        PG8_WAIT_V(4); PG8_BAR;
        PG8_STAGE(PG8_SB(1, 0), cB + kstep, voffB); PG8_STAGE(PG8_SA(1, 0), cA + kstep, voffA); PG8_STAGE(PG8_SB(1, 1), cB + hstep + kstep, voffB);
        PG8_WAIT_V(6); PG8_BAR;
    }
    for (;;) {
        const bool has_next = S.next(ui + 1, nxt);
        const char* nA = has_next ? (const char*)g.A + (size_t)nxt.pm * tstep : cA; const char* nB = has_next ? (const char*)g.Bt + (size_t)nxt.pn * tstep : cB;
        for (int t = 0; t < nt; t += 2) {
            const bool last = (t == nt - 2);
            const char* a1 = cA + (size_t)(t + 1) * kstep;
            const char* a2 = last ? nA : cA + (size_t)(t + 2) * kstep; const char* b2 = last ? nB : cB + (size_t)(t + 2) * kstep;
            const char* a3 = a2 + kstep; const char* b3 = b2 + kstep;
            if (last && has_next) S.a_ready(nxt);
            if constexpr (SP2) {
            PG8_LDB(B0, 0, 0); PG8_LDB(B1, 0, 1); PG8_SCHED; PG8_LDA(At, 0, 0); PG8_STAGE(PG8_SA(1, 1), a1 + hstep, voffA);
            PG8_WAIT_V(8); PG8_WAIT_L(0); PG8_BAR; PG8_MMA(0, 0, At, B0); PG8_MMA(0, 1, At, B1); PG8_BAR; PG8_SCHED;
            PG8_LDA(At, 0, 1); PG8_STAGE(PG8_SB(0, 0), b2, voffB); PG8_STAGE(PG8_SB(0, 1), b2 + hstep, voffB); PG8_STAGE(PG8_SA(0, 0), a2, voffA);
            PG8_WAIT_V(8); PG8_WAIT_L(0); PG8_BAR; PG8_MMA(1, 0, At, B0); PG8_MMA(1, 1, At, B1); PG8_BAR; PG8_SCHED;
            PG8_LDB(B0, 1, 0); PG8_LDB(B1, 1, 1); PG8_SCHED; PG8_LDA(At, 1, 0); PG8_STAGE(PG8_SA(0, 1), a2 + hstep, voffA);
            PG8_WAIT_V(8); PG8_WAIT_L(0); PG8_BAR; PG8_MMA(0, 0, At, B0); PG8_MMA(0, 1, At, B1); PG8_BAR; PG8_SCHED;
            PG8_LDA(At, 1, 1); PG8_STAGE(PG8_SB(1, 0), b3, voffB); PG8_STAGE(PG8_SB(1, 1), b3 + hstep, voffB); PG8_STAGE(PG8_SA(1, 0), a3, voffA);
            PG8_WAIT_V(8); PG8_WAIT_L(0); PG8_BAR; PG8_MMA(1, 0, At, B0); PG8_MMA(1, 1, At, B1); PG8_BAR; PG8_SCHED;
            } else {
            PG8_LDB(B0, 0, 0); PG8_SCHED; PG8_LDA(At, 0, 0); PG8_STAGE(PG8_SA(1, 1), a1 + hstep, voffA);
            PG8_WAIT_L(8); PG8_BAR; PG8_WAIT_L(0); PG8_MMA(0, 0, At, B0); PG8_BAR; PG8_SCHED;
            PG8_LDB(B1, 0, 1); PG8_STAGE(PG8_SB(0, 0), b2, voffB);
            PG8_BAR; PG8_WAIT_L(0); PG8_MMA(0, 1, At, B1); PG8_BAR;
            PG8_LDA(At, 0, 1); PG8_STAGE(PG8_SA(0, 0), a2, voffA);
            PG8_BAR; PG8_WAIT_L(0); PG8_MMA(1, 0, At, B0); PG8_BAR; PG8_SCHED;
            PG8_STAGE(PG8_SB(0, 1), b2 + hstep, voffB);
            PG8_WAIT_V(6); PG8_BAR; PG8_MMA(1, 1, At, B1); PG8_BAR;
            PG8_LDB(B0, 1, 0); PG8_SCHED; PG8_LDA(At, 1, 0); PG8_STAGE(PG8_SA(0, 1), a2 + hstep, voffA);
            PG8_WAIT_L(8); PG8_BAR; PG8_WAIT_L(0); PG8_MMA(0, 0, At, B0); PG8_BAR; PG8_SCHED;
            PG8_LDB(B1, 1, 1); PG8_STAGE(PG8_SB(1, 0), b3, voffB);
            PG8_BAR; PG8_WAIT_L(0); PG8_MMA(0, 1, At, B1); PG8_BAR;
            PG8_LDA(At, 1, 1); PG8_STAGE(PG8_SA(1, 0), a3, voffA);
            PG8_BAR; PG8_WAIT_L(0); PG8_MMA(1, 0, At, B0); PG8_BAR; PG8_SCHED;
            PG8_STAGE(PG8_SB(1, 1), b3 + hstep, voffB);
            PG8_WAIT_V(6); PG8_BAR; PG8_MMA(1, 1, At, B1); PG8_BAR;
            }
        }
        if constexpr (ALIGN_EPI) { if (wr == 0) PG8_BAR; }
        if constexpr (!Epi::AFTER_DRAIN) { E(acc, cur, wr, wc, fr, fq); S.done(cur); }
        if (!has_next) break;
#pragma unroll
        for (int a = 0; a < 2; ++a)
#pragma unroll
            for (int b = 0; b < 2; ++b)
#pragma unroll
                for (int m = 0; m < 4; ++m)
#pragma unroll
                    for (int n = 0; n < 2; ++n) acc[a][b][m][n] = (f32x4){0.f, 0.f, 0.f, 0.f};
        cur = nxt; cA = nA; cB = nB; ++ui;
        if constexpr (ALIGN_EPI) { if (wr == 1) PG8_BAR; }
    }
    PG8_WAIT_V(0);
    if constexpr (!ALIGN_EPI) { if (wr == 0) PG8_BAR; }
    PG8_BAR;
    if constexpr (Epi::AFTER_DRAIN) { E.fused(acc, cur, wr, wc, fr, fq, lds, wid, lane); S.done(cur); }
#undef PG8_SA
#undef PG8_SB
#undef PG8_STAGE
#undef PG8_LDA
#undef PG8_LDB
#undef PG8_MMA
#undef PG8_WAIT_V
#undef PG8_WAIT_L
#undef PG8_BAR
#undef PG8_SCHED
}
}

namespace pg8 {
struct EpiSwiglu {
    static constexpr bool PERM = true, AFTER_DRAIN = false;
    bf16_t* O; int ldc; const float* rs;
    __device__ __forceinline__ void operator()(const f32x4 (&acc)[2][2][4][2], const Unit& u, int wr, int wc, int fr, int fq) const {
        const int row0 = u.pm * BM + wr * 64 + fr; const int col0 = u.pn * HALF + wc * 32 + 8 * fq;
#pragma unroll
        for (int ai = 0; ai < 2; ++ai)
#pragma unroll
            for (int m = 0; m < 4; ++m) { const int r = row0 + ai * HALF + m * 16; bf16_t* rowp = O + (size_t)r * ldc + col0; const float sc = rs[r];
                float v[8];
#pragma unroll
                for (int n = 0; n < 2; ++n)
#pragma unroll
                    for (int i = 0; i < 4; ++i) { const float g = acc[ai][0][m][n][i] * sc, up = acc[ai][1][m][n][i] * sc;
                        v[n * 4 + i] = g * __builtin_amdgcn_rcpf(1.0f + __expf(-g)) * up; }
                u32x4 w; w.x = cvt_pk_bf16(v[0], v[1]); w.y = cvt_pk_bf16(v[2], v[3]); w.z = cvt_pk_bf16(v[4], v[5]); w.w = cvt_pk_bf16(v[6], v[7]);
                *(u32x4*)rowp = w; }
    }
};
struct EpiBf16S {
    static constexpr bool PERM = true, AFTER_DRAIN = false;
    bf16_t* O; int ldc; const float* rs; const float* cs;
    __device__ __forceinline__ void operator()(const f32x4 (&acc)[2][2][4][2], const Unit& u, int wr, int wc, int fr, int fq) const {
        const int row0 = u.pm * BM + wr * 64 + fr; const int col0 = u.pn * BM + wc * 32 + 8 * fq;
        f32x4 cv[2][2];
#pragma unroll
        for (int bj = 0; bj < 2; ++bj)
#pragma unroll
            for (int n = 0; n < 2; ++n) cv[bj][n] = cs ? *(const f32x4*)(cs + col0 + bj * HALF + 4 * n) : (f32x4){1.f, 1.f, 1.f, 1.f};
#pragma unroll
        for (int ai = 0; ai < 2; ++ai)
#pragma unroll
            for (int m = 0; m < 4; ++m) { const int r = row0 + ai * HALF + m * 16; bf16_t* rowp = O + (size_t)r * ldc + col0; const float sc = rs ? rs[r] : 1.f;
#pragma unroll
                for (int bj = 0; bj < 2; ++bj) { const f32x4 v0 = acc[ai][bj][m][0] * sc * cv[bj][0], v1 = acc[ai][bj][m][1] * sc * cv[bj][1];
                    u32x4 w; w.x = cvt_pk_bf16(v0[0], v0[1]); w.y = cvt_pk_bf16(v0[2], v0[3]); w.z = cvt_pk_bf16(v1[0], v1[1]); w.w = cvt_pk_bf16(v1[2], v1[3]);
                    *(u32x4*)(rowp + bj * HALF) = w; } }
    }
};
}

constexpr int NWAVES = 8;
constexpr int BATCH = 8, SEQ = 2048, D = 2048, M = BATCH * SEQ;
constexpr int DFF = 5632;
constexpr int GLA_H = 4, GLA_HK = 256, GLA_HV = 512, GLA_IN = 6160;
constexpr int DH = 8;
constexpr float EPS = 1e-6f;
constexpr float LAMBDA_INIT = 0.35550906758f;
constexpr float LOG2E = 1.4426950408889634f;

constexpr size_t MiB = 1u << 20;
constexpr size_t WS_WG = 1 * MiB;
constexpr size_t WS_WINA = 2 * MiB;
constexpr size_t WS_WINV = 18 * MiB;
constexpr size_t WS_WOUTA = 26 * MiB;
constexpr size_t WS_WGU0 = 34 * MiB, WS_WGU1 = 78 * MiB;
constexpr size_t WS_WDN0 = 122 * MiB, WS_WDN1 = 144 * MiB;
constexpr size_t WS_WKQ = 166 * MiB;
constexpr size_t WS_WV = 182 * MiB;
constexpr size_t WS_WOUTB = 190 * MiB;
constexpr size_t WS_BUFA = 198 * MiB;
constexpr size_t WS_BUFB = 262 * MiB;
constexpr size_t WS_GLR = 326 * MiB;
constexpr size_t WS_DEC = 327 * MiB;
constexpr size_t WS_RS = 1 * MiB + 131072;
constexpr size_t WS_ATT = 328 * MiB;
constexpr size_t WS_R1 = 336 * MiB;
constexpr size_t WS_VT = WS_R1 + 128 * MiB, WS_QD = WS_R1 + 192 * MiB, WS_KET = WS_R1 + 224 * MiB;
constexpr size_t WS_XN0 = WS_R1 + 256 * MiB;
constexpr size_t WS_END = WS_XN0 + 64 * MiB;
constexpr size_t WS_SQ0 = WS_RS + 65536;
constexpr int LDS_BYTES = 147456;
constexpr int MISC_OFF = LDS_BYTES - 64;
constexpr size_t WS_CTL = 0;

#define GAS __attribute__((address_space(1)))
#define LAS __attribute__((address_space(3)))
typedef unsigned short bf16;
typedef unsigned v4u __attribute__((ext_vector_type(4)));
typedef unsigned v2u __attribute__((ext_vector_type(2)));
typedef float f32x4 __attribute__((ext_vector_type(4)));
typedef float f32x16 __attribute__((ext_vector_type(16)));
typedef short bf16x8 __attribute__((ext_vector_type(8)));
typedef float f32x2_t __attribute__((ext_vector_type(2)));
typedef __bf16 bf16x2_t __attribute__((ext_vector_type(2)));
typedef LAS unsigned char* ldsp;

__device__ __forceinline__ unsigned cvtpk(float lo, float hi) { f32x2_t v = {lo, hi}; bf16x2_t b = __builtin_convertvector(v, bf16x2_t); return __builtin_bit_cast(unsigned, b); }
__device__ __forceinline__ float bflo(unsigned w) { return __uint_as_float(w << 16); }
__device__ __forceinline__ float bfhi(unsigned w) { return __uint_as_float(w & 0xffff0000u); }
__device__ __forceinline__ float bf1(bf16 b) { return __uint_as_float((unsigned)b << 16); }
__device__ __forceinline__ float wave_sum(float v) {
#pragma unroll
    for (int o = 1; o < 64; o <<= 1) v += __shfl_xor(v, o);
    return v;
}
__device__ __forceinline__ int pi32(int i) { return (i & ~12) | ((i & 4) << 1) | ((i & 8) >> 1); }
__device__ __forceinline__ bf16x8 ld8(ldsp p) { return *(const LAS bf16x8*)p; }
__device__ __forceinline__ void st16(ldsp p, v4u v) { *(LAS v4u*)p = v; }
#define MFMA32(a, b, c) __builtin_amdgcn_mfma_f32_32x32x16_bf16((a), (b), (c), 0, 0, 0)
#define MFMA16(a, b, c) __builtin_amdgcn_mfma_f32_16x16x32_bf16((a), (b), (c), 0, 0, 0)

struct P0Desc { const float* src; const float* gain; bf16* dst; int ldw, K, mode, n0; };
__device__ __forceinline__ void p0_load(const P0Desc& d, f32x4 (&R)[16], int lane) {
    const float* p = d.src + (size_t)(lane >> 4) * d.ldw + (lane & 15) * 4;
#pragma unroll
    for (int i = 0; i < 16; ++i) R[i] = __builtin_nontemporal_load((const f32x4*)(p + (size_t)(4 * i) * d.ldw));
}
__device__ __forceinline__ void p0_to_lds(const f32x4 (&R)[16], LAS float* scr, int lane) {
#pragma unroll
    for (int i = 0; i < 16; ++i) *(LAS f32x4*)(scr + (4 * i + (lane >> 4)) * 68 + (lane & 15) * 4) = R[i];
}
__device__ __forceinline__ void p0_emit(const P0Desc& d, const LAS float* scr, int lane) {
    const int c = lane & 7;
    f32x4 g0 = {1.f, 1.f, 1.f, 1.f}, g1 = g0;
    if (d.gain) { g0 = *(const f32x4*)(d.gain + 8 * c); g1 = *(const f32x4*)(d.gain + 8 * c + 4); }
#pragma unroll
    for (int j = 0; j < 8; ++j) { const int n = (lane >> 3) + 8 * j; const LAS float* s = scr + (8 * c) * 68 + n;
        v4u o; o.x = cvtpk(s[0 * 68] * g0[0], s[1 * 68] * g0[1]); o.y = cvtpk(s[2 * 68] * g0[2], s[3 * 68] * g0[3]); o.z = cvtpk(s[4 * 68] * g1[0], s[5 * 68] * g1[1]); o.w = cvtpk(s[6 * 68] * g1[2], s[7 * 68] * g1[3]);
        const int cn = d.n0 + n; int drow;
        if (d.mode == 0) drow = cn; else { const int f = cn < DFF ? cn : cn - DFF; drow = 256 * (f >> 7) + (f & 127) + (cn < DFF ? 0 : 128); }
        *(v4u*)(d.dst + (size_t)drow * d.K + 8 * c) = o; }
}

__device__ __forceinline__ void rms_row(const float* xrow, bf16* orow, int lane) {
    const f32x4* xr = (const f32x4*)xrow + lane;
    f32x4 v[8]; float s = 0.f;
#pragma unroll
    for (int j = 0; j < 8; ++j) { v[j] = xr[64 * j]; s += (v[j].x * v[j].x + v[j].y * v[j].y) + (v[j].z * v[j].z + v[j].w * v[j].w); }
    const float rstd = 1.0f / sqrtf(wave_sum(s) * (1.f / D) + EPS);
    v2u* o8 = (v2u*)orow + lane;
#pragma unroll
    for (int j = 0; j < 8; ++j) { v2u w; w.x = cvtpk(v[j].x * rstd, v[j].y * rstd); w.y = cvtpk(v[j].z * rstd, v[j].w * rstd); o8[64 * j] = w; }
}

template <bool BASE_F32, bool OUT_F32>
__device__ __forceinline__ void norm_res_phase(const void* base, const bf16* src, const float* g, void* out, float* rs, const float* bsc, int gw, int NGW, int lane) {
    for (int m0 = 2 * gw; m0 < M; m0 += 2 * NGW) {
        f32x4 bv[2][8]; v2u sv[2][8];
#pragma unroll
        for (int r = 0; r < 2; ++r) { const v2u* sr = (const v2u*)(src + (size_t)(m0 + r) * D) + lane;
#pragma unroll
            for (int j = 0; j < 8; ++j) sv[r][j] = __builtin_nontemporal_load(sr + 64 * j); }
#pragma unroll
        for (int r = 0; r < 2; ++r) {
            if (BASE_F32) { const f32x4* br = (const f32x4*)((const float*)base + (size_t)(m0 + r) * D) + lane;
#pragma unroll
                for (int j = 0; j < 8; ++j) bv[r][j] = __builtin_nontemporal_load(br + 64 * j); }
            else { const v2u* br = (const v2u*)((const bf16*)base + (size_t)(m0 + r) * D) + lane;
#pragma unroll
                for (int j = 0; j < 8; ++j) { const v2u w = br[64 * j]; bv[r][j] = (f32x4){bflo(w.x), bfhi(w.x), bflo(w.y), bfhi(w.y)}; }
                if (bsc) { const float sc = bsc[m0 + r];
#pragma unroll
                    for (int j = 0; j < 8; ++j) bv[r][j] = bv[r][j] * sc; } }
        }
#pragma unroll
        for (int r = 0; r < 2; ++r) {
            f32x4 v[8]; float ss = 0.f;
#pragma unroll
            for (int j = 0; j < 8; ++j) { const v2u w = sv[r][j]; v[j] = (f32x4){bflo(w.x), bfhi(w.x), bflo(w.y), bfhi(w.y)}; ss += (v[j].x * v[j].x + v[j].y * v[j].y) + (v[j].z * v[j].z + v[j].w * v[j].w); }
            const float rstd = 1.0f / sqrtf(wave_sum(ss) * (1.f / D) + EPS);
            float s2 = 0.f;
#pragma unroll
            for (int j = 0; j < 8; ++j) { const f32x4 gv = ((const f32x4*)g)[lane + 64 * j]; v[j] = bv[r][j] + v[j] * rstd * gv;
                s2 += (v[j].x * v[j].x + v[j].y * v[j].y) + (v[j].z * v[j].z + v[j].w * v[j].w); }
            if (OUT_F32) { f32x4* orow = (f32x4*)((float*)out + (size_t)(m0 + r) * D) + lane;
#pragma unroll
                for (int j = 0; j < 8; ++j) __builtin_nontemporal_store(v[j], orow + 64 * j); }
            else { v2u* orow = (v2u*)((bf16*)out + (size_t)(m0 + r) * D) + lane;
#pragma unroll
                for (int j = 0; j < 8; ++j) { v2u w; w.x = cvtpk(v[j].x, v[j].y); w.y = cvtpk(v[j].z, v[j].w); orow[64 * j] = w; } }
            if (rs) { const float r2 = 1.0f / sqrtf(wave_sum(s2) * (1.f / D) + EPS); if (lane == 0) rs[m0 + r] = r2; }
        }
    }
}

__device__ __forceinline__ void glr_phase(ldsp lds, const bf16* XN, const bf16* WG, float* GLR, int G, int tid) {
    asm volatile("" : "+v"(tid));
    const int lane = tid & 63, w = __builtin_amdgcn_readfirstlane(tid >> 6), rb = w & 3, kh = w >> 2, i = lane & 15, q = lane >> 4;
    LAS float* red = (LAS float*)lds;
    for (int blk = blockIdx.x; blk < M / 64; blk += G) {
        const bf16* ap = XN + (size_t)(blk * 64 + rb * 16 + i) * D + kh * 1024 + 8 * q;
        const bf16* bp = WG + (size_t)i * D + kh * 1024 + 8 * q;
        f32x4 acc = {0.f, 0.f, 0.f, 0.f};
#pragma unroll 8
        for (int s = 0; s < 32; ++s) { const bf16x8 a = *(const bf16x8*)(ap + 32 * s); const bf16x8 b = *(const bf16x8*)(bp + 32 * s); acc = MFMA16(a, b, acc); }
        if (kh == 1) *(LAS f32x4*)(red + (rb * 64 + lane) * 4) = acc;
        __syncthreads();
        if (kh == 0) { const f32x4 o = *(LAS f32x4*)(red + (rb * 64 + lane) * 4); acc = acc + o;
#pragma unroll
            for (int r = 0; r < 4; ++r) GLR[(size_t)(blk * 64 + rb * 16 + 4 * q + r) * 16 + i] = acc[r]; }
        __syncthreads();
    }
}

__device__ __forceinline__ void gla_pre_phase(ldsp lds, const bf16* PROJ, const float* GLR, const float* wfg, const float* bfg, bf16* QDg, bf16* KETg, bf16* ATTg, float* DECg, int vcu, int G, int tid) {
    asm volatile("" : "+v"(tid));
    const int lane = tid & 63, w = __builtin_amdgcn_readfirstlane(tid >> 6), r32 = lane & 31, hi = lane >> 5;
    const int d = tid & 255, half = tid >> 8;
    const ldsp QD = lds, KI = lds + 33792;
    LAS float* GL = (LAS float*)(lds + 67584); LAS float* TOT = (LAS float*)(lds + 71680); LAS float* RED = (LAS float*)(lds + 73728);
    v4u pq[4], pk[4]; f32x4 pg = {0.f, 0.f, 0.f, 0.f};
#define G1_PREFETCH(it_) do { const int b_ = (it_) >> 7, h_ = ((it_) >> 5) & 3, n_ = (it_) & 31; const int t0_ = b_ * SEQ + n_ * 64; \
        _Pragma("unroll") for (int cc = 0; cc < 4; ++cc) { const int idx = tid + 512 * cc; const bf16* gp = PROJ + (size_t)(t0_ + (idx >> 5)) * 4096 + h_ * 256 + (idx & 31) * 8; pq[cc] = *(const v4u*)gp; pk[cc] = *(const v4u*)(gp + 1024); } \
        if (tid < 256) pg = *(const f32x4*)(GLR + (size_t)t0_ * 16 + tid * 4); } while (0)
    if (vcu < 1024) G1_PREFETCH(vcu);
    float wf[16], bias = 0.f; int hprev = -1;
#pragma unroll
    for (int r = 0; r < 16; ++r) wf[r] = 0.f;
    for (int item = vcu; item < 1024; item += G) {
        const int b = item >> 7, h = (item >> 5) & 3, n = item & 31; const int tok0 = b * SEQ + n * 64;
#pragma unroll
        for (int cc = 0; cc < 4; ++cc) { const int idx = tid + 512 * cc, row = idx >> 5, ch = idx & 31; st16(QD + (row * 264 + ch * 8) * 2, pq[cc]); st16(KI + (row * 264 + ch * 8) * 2, pk[cc]); }
        if (tid < 256) *(LAS f32x4*)(GL + tid * 4) = pg;
        { const int nit = item + G; if (nit < 1024) G1_PREFETCH(nit); }
        if (h != hprev) { hprev = h;
#pragma unroll
            for (int r = 0; r < 16; ++r) wf[r] = wfg[r * 1024 + h * 256 + d] * LOG2E;
            bias = bfg[h * 256 + d] * LOG2E; }
        __syncthreads();
        float bc[32]; float c = 0.f;
#pragma unroll
        for (int t = 0; t < 32; ++t) { const LAS float* gr = GL + (half * 32 + t) * 16; float z = bias;
#pragma unroll
            for (int r = 0; r < 16; ++r) z += gr[r] * wf[r];
            const float ls = fmaxf(-z, 0.f) + __builtin_amdgcn_logf(1.0f + __builtin_amdgcn_exp2f(-fabsf(z)));
            c -= ls * (1.0f / 16.0f); bc[t] = c; }
        TOT[half * 256 + d] = c;
        __syncthreads();
        const float tot0 = TOT[d], tot1 = TOT[256 + d]; const float blast = tot0 + tot1; const float add = half ? tot0 : 0.f;
        unsigned ke[16];
#pragma unroll
        for (int t = 0; t < 32; ++t) { const float bcv = bc[t] + add; const int row = half * 32 + t;
            const float qv = bf1(*(const LAS bf16*)(QD + (row * 264 + d) * 2)), kv = bf1(*(const LAS bf16*)(KI + (row * 264 + d) * 2));
            const float qd = qv * 0.0625f * __builtin_amdgcn_exp2f(bcv); const float ki = kv * __builtin_amdgcn_exp2f(-bcv); const float kev = kv * __builtin_amdgcn_exp2f(blast - bcv);
            *(LAS bf16*)(QD + (row * 264 + d) * 2) = (bf16)(cvtpk(qd, 0.f) & 0xffffu);
            *(LAS bf16*)(KI + (row * 264 + d) * 2) = (bf16)(cvtpk(ki, 0.f) & 0xffffu);
            if (t & 1) ke[t >> 1] |= cvtpk(0.f, kev) & 0xffff0000u; else ke[t >> 1] = cvtpk(kev, 0.f) & 0xffffu; }
        { v4u* kp = (v4u*)(KETg + (size_t)item * 16384 + d * 64 + half * 32);
#pragma unroll
          for (int j = 0; j < 4; ++j) kp[j] = (v4u){ke[4 * j], ke[4 * j + 1], ke[4 * j + 2], ke[4 * j + 3]}; }
        if (half == 0) DECg[item * 256 + d] = __builtin_amdgcn_exp2f(blast);
        __syncthreads();
#pragma unroll
        for (int cc = 0; cc < 4; ++cc) { const int idx = tid + 512 * cc, row = idx >> 5, ch = idx & 31; *(v4u*)(QDg + (size_t)item * 16384 + row * 256 + ch * 8) = *(const LAS v4u*)(QD + (row * 264 + ch * 8) * 2); }
        { const int tile = w & 3, ti = tile >> 1, si = tile & 1, kh = w >> 2;
          f32x16 acc = {};
          const ldsp ap = KI + ((32 * si + pi32(r32)) * 264 + kh * 128 + 8 * hi) * 2; const ldsp bp = QD + ((32 * ti + r32) * 264 + kh * 128 + 8 * hi) * 2;
#pragma unroll
          for (int s = 0; s < 8; ++s) acc = MFMA32(ld8(ap + s * 32), ld8(bp + s * 32), acc);
          if (kh == 1) {
#pragma unroll
              for (int r = 0; r < 16; ++r) RED[(tile * 16 + r) * 64 + lane] = acc[r]; }
          __syncthreads();
          if (kh == 0) { const int t = 32 * ti + r32; unsigned pk[8];
#pragma unroll
              for (int r = 0; r < 16; r += 2) { float v0 = acc[r] + RED[(tile * 16 + r) * 64 + lane], v1 = acc[r + 1] + RED[(tile * 16 + r + 1) * 64 + lane];
                  const int s0 = 32 * si + 16 * (r >> 3) + 8 * hi + (r & 7);
                  if (s0 > t) v0 = 0.f; if (s0 + 1 > t) v1 = 0.f; pk[r >> 1] = cvtpk(v0, v1); }
              bf16* op = ATTg + (size_t)item * 4096 + t * 64 + 32 * si + 8 * hi;
              *(v4u*)op = (v4u){pk[0], pk[1], pk[2], pk[3]}; *(v4u*)(op + 16) = (v4u){pk[4], pk[5], pk[6], pk[7]}; }
        }
        __syncthreads();
    }
}

#undef G1_PREFETCH
__device__ __forceinline__ void gla_scan_phase(ldsp lds, const bf16* QDg, const bf16* KETg, const bf16* ATTg, const float* DECg, const bf16* VTg, bf16* O1, int vcu, int G, int tid) {
    asm volatile("" : "+v"(tid));
    const int lane = tid & 63, w = __builtin_amdgcn_readfirstlane(tid >> 6), r32 = lane & 31, hi = lane >> 5, i16 = lane & 15, q4 = lane >> 4;
    const ldsp QD = lds, KET = lds + 33792, ATT = lds + 70656, VT = lds + 79872, ST = lds + 89088; LAS float* DEC = (LAS float*)(lds + 122880);
    for (int item = vcu; item < 256; item += G) {
        const int bh = item >> 3, b = bh >> 2, h = bh & 3, j = item & 7;
        f32x16 st[2]; st[0] = (f32x16){}; st[1] = (f32x16){};
        __syncthreads();
        for (int u = tid; u < 33792 / 16; u += 512) st16(ST + u * 16, (v4u){0u, 0u, 0u, 0u});
        v4u rq[4], rk[4], ra, rv; f32x4 rd = {0.f, 0.f, 0.f, 0.f};
#define G2_LOAD(nn) do { const size_t cb = (size_t)(bh * 32 + (nn)); const int tok0_ = b * SEQ + (nn) * 64; \
        _Pragma("unroll") for (int cc = 0; cc < 4; ++cc) { rq[cc] = *(const v4u*)(QDg + cb * 16384 + (size_t)(tid + 512 * cc) * 8); rk[cc] = *(const v4u*)(KETg + cb * 16384 + (size_t)(tid + 512 * cc) * 8); } \
        ra = *(const v4u*)(ATTg + cb * 4096 + tid * 8); rv = *(const v4u*)(VTg + (size_t)(h * 512 + j * 64 + (tid >> 3)) * M + tok0_ + (tid & 7) * 8); \
        if (tid < 64) rd = *(const f32x4*)(DECg + cb * 256 + tid * 4); } while (0)
#define G2_STORE() do { _Pragma("unroll") for (int cc = 0; cc < 4; ++cc) { const int idx = tid + 512 * cc; st16(QD + ((idx >> 5) * 264 + (idx & 31) * 8) * 2, rq[cc]); st16(KET + ((idx >> 3) * 72 + (idx & 7) * 8) * 2, rk[cc]); } \
        st16(ATT + ((tid >> 3) * 72 + (tid & 7) * 8) * 2, ra); st16(VT + ((tid >> 3) * 72 + (tid & 7) * 8) * 2, rv); if (tid < 64) *(LAS f32x4*)(DEC + tid * 4) = rd; } while (0)
        G2_LOAD(0);
        G2_STORE();
        for (int n = 0; n < 32; ++n) {
            if (n + 1 < 32) G2_LOAD(n + 1);
            __syncthreads();
            { const int tb = w & 3, ebp = w >> 2; f32x4 a0 = {0.f, 0.f, 0.f, 0.f}, a1 = {0.f, 0.f, 0.f, 0.f};
              const ldsp bA = ATT + ((16 * tb + i16) * 72 + 8 * q4) * 2, bQ = QD + ((16 * tb + i16) * 264 + 8 * q4) * 2;
              const ldsp v0 = VT + ((32 * ebp + i16) * 72 + 8 * q4) * 2, v1 = v0 + 16 * 72 * 2;
              const ldsp s0 = ST + ((32 * ebp + i16) * 264 + 8 * q4) * 2, s1 = s0 + 16 * 264 * 2;
              bf16x8 bb[10], aa[8];
#pragma unroll
              for (int ks = 0; ks < 2; ++ks) bb[ks] = ld8(bA + ks * 64);
#pragma unroll
              for (int ks = 0; ks < 8; ++ks) bb[2 + ks] = ld8(bQ + ks * 64);
              aa[0] = ld8(v0); aa[1] = ld8(v1); aa[2] = ld8(v0 + 64); aa[3] = ld8(v1 + 64); aa[4] = ld8(s0); aa[5] = ld8(s1); aa[6] = ld8(s0 + 64); aa[7] = ld8(s1 + 64);
              __builtin_amdgcn_sched_barrier(0);
#pragma unroll
              for (int i = 0; i < 4; ++i) { a0 = MFMA16(aa[2 * i], bb[i], a0); a1 = MFMA16(aa[2 * i + 1], bb[i], a1); }
              __builtin_amdgcn_sched_barrier(0);
#pragma unroll
              for (int i = 0; i < 4; ++i) { aa[2 * i] = ld8(s0 + (2 + i) * 64); aa[2 * i + 1] = ld8(s1 + (2 + i) * 64); }
              __builtin_amdgcn_sched_barrier(0);
#pragma unroll
              for (int i = 0; i < 4; ++i) { a0 = MFMA16(aa[2 * i], bb[4 + i], a0); a1 = MFMA16(aa[2 * i + 1], bb[4 + i], a1); }
              __builtin_amdgcn_sched_barrier(0);
#pragma unroll
              for (int i = 0; i < 2; ++i) { aa[2 * i] = ld8(s0 + (6 + i) * 64); aa[2 * i + 1] = ld8(s1 + (6 + i) * 64); }
              __builtin_amdgcn_sched_barrier(0);
#pragma unroll
              for (int i = 0; i < 2; ++i) { a0 = MFMA16(aa[2 * i], bb[8 + i], a0); a1 = MFMA16(aa[2 * i + 1], bb[8 + i], a1); }
              __builtin_amdgcn_sched_barrier(0);
              bf16* op = O1 + (size_t)(b * SEQ + n * 64 + 16 * tb + i16) * D + h * 512 + j * 64 + 32 * ebp + 4 * q4;
              *(v2u*)op = (v2u){cvtpk(a0[0], a0[1]), cvtpk(a0[2], a0[3])}; *(v2u*)(op + 16) = (v2u){cvtpk(a1[0], a1[1]), cvtpk(a1[2], a1[3])}; }
            { float dc[16];
#pragma unroll
              for (int g = 0; g < 2; ++g) { const f32x4 x0 = *(const LAS f32x4*)(DEC + 32 * w + 16 * g + 8 * hi), x1 = *(const LAS f32x4*)(DEC + 32 * w + 16 * g + 8 * hi + 4);
                  dc[8 * g + 0] = x0[0]; dc[8 * g + 1] = x0[1]; dc[8 * g + 2] = x0[2]; dc[8 * g + 3] = x0[3]; dc[8 * g + 4] = x1[0]; dc[8 * g + 5] = x1[1]; dc[8 * g + 6] = x1[2]; dc[8 * g + 7] = x1[3]; }
              const ldsp ka = KET + ((32 * w + pi32(r32)) * 72 + 8 * hi) * 2; const ldsp vb0 = VT + (r32 * 72 + 8 * hi) * 2, vb1 = vb0 + 32 * 72 * 2;
              bf16x8 ka4[4], va4[4], vb4[4];
#pragma unroll
              for (int ks = 0; ks < 4; ++ks) { ka4[ks] = ld8(ka + ks * 32); va4[ks] = ld8(vb0 + ks * 32); vb4[ks] = ld8(vb1 + ks * 32); }
#pragma unroll
              for (int r = 0; r < 16; ++r) { st[0][r] *= dc[r]; st[1][r] *= dc[r]; }
              __builtin_amdgcn_sched_barrier(0);
#pragma unroll
              for (int ks = 0; ks < 4; ++ks) { st[0] = MFMA32(ka4[ks], va4[ks], st[0]); st[1] = MFMA32(ka4[ks], vb4[ks], st[1]); }
              __builtin_amdgcn_sched_barrier(0); }
            __syncthreads();
#pragma unroll
            for (int eb = 0; eb < 2; ++eb)
#pragma unroll
                for (int g = 0; g < 2; ++g) st16(ST + ((32 * eb + r32) * 264 + 32 * w + 16 * g + 8 * hi) * 2,
                    (v4u){cvtpk(st[eb][8 * g], st[eb][8 * g + 1]), cvtpk(st[eb][8 * g + 2], st[eb][8 * g + 3]), cvtpk(st[eb][8 * g + 4], st[eb][8 * g + 5]), cvtpk(st[eb][8 * g + 6], st[eb][8 * g + 7])});
            if (n + 1 < 32) G2_STORE();
        }
#undef G2_LOAD
#undef G2_STORE
    }
}

__device__ __forceinline__ void gla_gate_phase(const bf16* O1, const bf16* PROJ, const float* gn, bf16* A2, int gw, int NGW, int lane) {
    const f32x4 g0 = *(const f32x4*)(gn + lane * 8), g1 = *(const f32x4*)(gn + lane * 8 + 4);
    const float g[8] = {g0[0], g0[1], g0[2], g0[3], g1[0], g1[1], g1[2], g1[3]};
    const bool aff = (NGW == 2048);
    for (int it = 0, tok = aff ? 2048 * (gw >> 8) + (gw & 255) : gw; aff ? it < 8 : tok < M; ++it, tok += aff ? 256 : NGW) {
        v4u ov[4], rv[4];
#pragma unroll
        for (int h = 0; h < 4; ++h) { ov[h] = __builtin_nontemporal_load((const v4u*)(O1 + (size_t)tok * D + h * 512 + lane * 8)); rv[h] = __builtin_nontemporal_load((const v4u*)(PROJ + (size_t)tok * 4096 + 2048 + h * 512 + lane * 8)); }
#pragma unroll
        for (int h = 0; h < 4; ++h) {
            float o[8] = {bflo(ov[h].x), bfhi(ov[h].x), bflo(ov[h].y), bfhi(ov[h].y), bflo(ov[h].z), bfhi(ov[h].z), bflo(ov[h].w), bfhi(ov[h].w)};
            float r[8] = {bflo(rv[h].x), bfhi(rv[h].x), bflo(rv[h].y), bfhi(rv[h].y), bflo(rv[h].z), bfhi(rv[h].z), bflo(rv[h].w), bfhi(rv[h].w)};
            float ss = 0.f;
#pragma unroll
            for (int i = 0; i < 8; ++i) ss += o[i] * o[i];
            const float rstd = 1.0f / sqrtf(wave_sum(ss) * (1.f / 512.f) + EPS);
            float y[8];
#pragma unroll
            for (int i = 0; i < 8; ++i) y[i] = o[i] * rstd * g[i] * (r[i] * __builtin_amdgcn_rcpf(1.0f + __expf(-r[i])));
            *(v4u*)(A2 + (size_t)tok * D + h * 512 + lane * 8) = (v4u){cvtpk(y[0], y[1]), cvtpk(y[2], y[3]), cvtpk(y[4], y[5]), cvtpk(y[6], y[7])}; }
    }
}
#define XB_TMO      128
#define XB_XCNT(j)  (256  + 64 * (j))
#define XB_XSUB(j)  (1280 + 64 * (j))
#define XB_XGEN(j)  (2304 + 64 * (j))
#define XB_TOP      3328
#define XB_TOPGEN   3392
#define XCD_BAR_WORDS 3456
#define XB_SPIN_CAP (1u << 18)

__device__ __forceinline__ unsigned xb_ld(unsigned* p)              { return __hip_atomic_load(p, __ATOMIC_RELAXED, __HIP_MEMORY_SCOPE_AGENT); }
__device__ __forceinline__ unsigned xb_add(unsigned* p, unsigned v) { return __hip_atomic_fetch_add(p, v, __ATOMIC_RELAXED, __HIP_MEMORY_SCOPE_AGENT); }
__device__ __forceinline__ unsigned xb_xcc_id() { return (unsigned)__builtin_amdgcn_s_getreg((3 << 11) | 20) & 0xFu; }
#define XB_SPIN(cond, bar) do { unsigned _sp = 0; while (cond) { __builtin_amdgcn_s_sleep(1); \
    if ((++_sp & 255u) == 0u) { if (xb_ld(&(bar)[XB_TMO])) break; if (_sp > XB_SPIN_CAP) { atomicAdd(&(bar)[XB_TMO], 1u); break; } } } } while (0)

struct XcdBarrier {
    unsigned* bar; unsigned x;
    volatile LAS unsigned* st;
};

__device__ __forceinline__ XcdBarrier xcd_barrier_post(unsigned* bar, volatile LAS unsigned* st) {
    XcdBarrier b; b.bar = bar; b.x = xb_xcc_id(); b.st = st;
    if (threadIdx.x == 0) (void)xb_add(&bar[XB_XCNT(b.x)], 1u);
    return b;
}
__device__ __forceinline__ void xcd_barrier_complete(unsigned* bar, unsigned x, unsigned& nloc, unsigned& nx) {
    const unsigned G = gridDim.x * gridDim.y * gridDim.z;
    unsigned sum, cnt, mine, sp = 0u;
    for (;;) {
        sum = 0u; cnt = 0u; mine = 0u;
#pragma unroll
        for (unsigned j = 0; j < 16; ++j) { const unsigned c = xb_ld(&bar[XB_XCNT(j)]); sum += c; cnt += (c > 0u) ? 1u : 0u; mine = (j == x) ? c : mine; }
        if (sum == G) break;
        __builtin_amdgcn_s_sleep(1);
        if ((++sp & 255u) == 0u) { if (xb_ld(&bar[XB_TMO])) break; if (sp > XB_SPIN_CAP) { atomicAdd(&bar[XB_TMO], 1u); break; } }
    }
    nloc = mine > 0u ? mine : 1u; nx = cnt > 0u ? cnt : 1u;
}

__device__ __forceinline__ void xcd_barrier(const XcdBarrier& b) {
    asm volatile("s_waitcnt vmcnt(0)" ::: "memory");
    __syncthreads();
    if (threadIdx.x == 0) {
        unsigned* bar = b.bar;
        __builtin_amdgcn_s_waitcnt(0);
        unsigned nloc = b.st[0], nx = b.st[1];
        if (nloc == 0u) { xcd_barrier_complete(bar, b.x, nloc, nx); b.st[0] = nloc; b.st[1] = nx; }
        const unsigned old = xb_add(&bar[XB_XSUB(b.x)], 1u);
        const unsigned gen = old / nloc;
        if (old + 1u == (gen + 1u) * nloc) {
            __builtin_amdgcn_fence(__ATOMIC_RELEASE, "agent");
            asm volatile("s_waitcnt vmcnt(0)" ::: "memory");
            const unsigned og = xb_add(&bar[XB_TOP], 1u);
            const unsigned tg = og / nx;
            if (og + 1u == (tg + 1u) * nx) xb_add(&bar[XB_TOPGEN], 1u);
            else XB_SPIN(xb_ld(&bar[XB_TOPGEN]) == tg, bar);
            __builtin_amdgcn_fence(__ATOMIC_ACQUIRE, "agent");
            xb_add(&bar[XB_XGEN(b.x)], 1u);
            asm volatile("s_waitcnt vmcnt(0)" ::: "memory");
        } else {
            XB_SPIN(xb_ld(&bar[XB_XGEN(b.x)]) == gen, bar);
            __builtin_amdgcn_fence(__ATOMIC_ACQUIRE, "agent");
            asm volatile("s_waitcnt vmcnt(0)" ::: "memory");
        }
    }
    __syncthreads();
}

__device__ __forceinline__ void attn_phase(ldsp lds, const bf16* KQ, const bf16* VTa, const float* relb, const float* lq1, const float* lk1, const float* lq2, const float* lk2,
                                           const float* subg, bf16* O2, int vcu, int G, int tid) {
    asm volatile("" : "+v"(tid));
    const int lane = tid & 63, w = __builtin_amdgcn_readfirstlane(tid >> 6), i16 = lane & 15, g4 = lane >> 4;
    const int mh = w >> 2, qb4 = w & 3;
    constexpr int ABUF = 65536;
    LAS float* TB = (LAS float*)(lds + 2 * ABUF); LAS float* LAMS = (LAS float*)(lds + 2 * ABUF + 1024); LAS float* XO = (LAS float*)lds;
    if (w == 0) { float a = lq1[lane] * lk1[lane] + lq1[lane + 64] * lk1[lane + 64], b = lq2[lane] * lk2[lane] + lq2[lane + 64] * lk2[lane + 64];
        a = wave_sum(a); b = wave_sum(b); if (lane == 0) LAMS[0] = expf(a) - expf(b) + LAMBDA_INIT; }
    const float c1 = 0.08838834764831845f * LOG2E;
    for (int v = vcu; v < 256; v += G) {
        const int h = v >> 5, cq = v & 31;
        __syncthreads();
        { int t2 = tid; asm volatile("" : "+v"(t2));
          if (t2 < 129) { int bucket; if (t2 < 16) bucket = t2; else { bucket = 16 + (int)(logf((float)t2 * (1.0f / 16.0f)) / 2.0794415416798357f * 16.0f); if (bucket > 31) bucket = 31; }
            TB[t2] = relb[bucket * 8 + h] * 11.313708498984761f; } }
        for (int ui = 0; ui < 8; ++ui) {
            const int b = ui; const int qb = (ui & 1) ? 31 - cq : cq;
            const int q0 = qb * 64; const int qrow = 16 * qb4 + i16; const size_t tokq = (size_t)b * SEQ + q0 + qrow;
            bf16x8 qf[4];
#pragma unroll
            for (int ks = 0; ks < 4; ++ks) qf[ks] = *(const bf16x8*)(KQ + tokq * 4096 + 2048 + h * 256 + mh * 128 + 32 * ks + 8 * g4);
            f32x4 o[16];
#pragma unroll
            for (int eb = 0; eb < 16; ++eb) o[eb] = (f32x4){0.f, 0.f, 0.f, 0.f};
            float mrun = -INFINITY, lrun = 0.f;
            unsigned kdo[4], vdo[4];
#pragma unroll
            for (int cc = 0; cc < 4; ++cc) { const int p = 4 * w + cc;
                const int lr = 2 * p + (lane >> 5), ch = (lane & 31) ^ (lr & 15), i_ = lr & 15, t_ = (lr >> 4) & 1, gr = (lr & ~31) + 8 * (i_ >> 2) + 4 * t_ + (i_ & 3);
                kdo[cc] = (unsigned)(gr * 4096 + ch * 8);
                const int le = 8 * p + (lane >> 3), cv = (lane & 7) ^ ((le >> 1) & 7), iv = le & 15, tv = (le >> 4) & 1, ge = (le & ~31) + 8 * (iv >> 2) + 4 * tv + (iv & 3);
                vdo[cc] = (unsigned)(ge * M + cv * 8); }
#define AT_DMA(kt_, bs_) do { const bf16* kb_ = KQ + ((size_t)b * SEQ + 64 * (kt_)) * 4096 + h * 256; const bf16* vb_ = VTa + (size_t)(h * 256) * M + (size_t)b * SEQ + 64 * (kt_); \
            _Pragma("unroll") for (int cc = 0; cc < 4; ++cc) { \
                __builtin_amdgcn_global_load_lds((const unsigned*)(kb_ + kdo[cc]), (LAS unsigned*)(lds + (bs_) * ABUF + (4 * w + cc) * 1024), 16, 0, 0); \
                __builtin_amdgcn_global_load_lds((const unsigned*)(vb_ + vdo[cc]), (LAS unsigned*)(lds + (bs_) * ABUF + 32768 + (4 * w + cc) * 1024), 16, 0, 0); } } while (0)
            __syncthreads();
            AT_DMA(0, 0);
            asm volatile("s_waitcnt vmcnt(0)" : "+v"(qf[0]), "+v"(qf[1]), "+v"(qf[2]), "+v"(qf[3]) :: "memory");
            for (int kt = 0; kt <= qb; ++kt) {
                asm volatile("s_waitcnt vmcnt(0)" ::: "memory"); __syncthreads();
                if (kt + 1 <= qb) AT_DMA(kt + 1, (kt + 1) & 1);
                const ldsp Kb = lds + (kt & 1) * ABUF + i16 * 512 + mh * 256, Vb = lds + (kt & 1) * ABUF + 32768 + i16 * 128;
                const int kx = g4 ^ i16, vx = g4 ^ (i16 >> 1);
                const ldsp kbs0 = Kb + kx * 16, kbs1 = Kb + (kx ^ 4) * 16, kbs2 = Kb + (kx ^ 8) * 16, kbs3 = Kb + (kx ^ 12) * 16, vbs0 = Vb + vx * 16, vbs1 = Vb + (vx ^ 4) * 16;
                const int k0 = 64 * kt;
#define SB() __builtin_amdgcn_sched_barrier(0)
#define LDK(dst, hf_, bt_) do { _Pragma("unroll") for (int j_ = 0; j_ < 2; ++j_) _Pragma("unroll") for (int t_ = 0; t_ < 2; ++t_) dst[2 * j_ + t_] = ld8(((2 * (bt_) + j_) == 0 ? kbs0 : (2 * (bt_) + j_) == 1 ? kbs1 : (2 * (bt_) + j_) == 2 ? kbs2 : kbs3) + (32 * (hf_) + 16 * t_) * 512); } while (0)
#define LDV(dst, hf_, bt_) do { _Pragma("unroll") for (int j_ = 0; j_ < 4; ++j_) dst[j_] = ld8(((hf_) == 0 ? vbs0 : vbs1) + (4 * (bt_) + j_) * 16 * 128); } while (0)
#define MMK(src, bt_) do { s[0] = MFMA16(src[0], qf[2 * (bt_)], s[0]); s[1] = MFMA16(src[1], qf[2 * (bt_)], s[1]); s[0] = MFMA16(src[2], qf[2 * (bt_) + 1], s[0]); s[1] = MFMA16(src[3], qf[2 * (bt_) + 1], s[1]); } while (0)
#define MMV(src, bt_) do { _Pragma("unroll") for (int j_ = 0; j_ < 4; ++j_) o[4 * (bt_) + j_] = MFMA16(src[j_], pb, o[4 * (bt_) + j_]); } while (0)
                bf16x8 X[4], Y[4];
                LDK(X, 0, 0); SB();
#pragma unroll
                for (int hf = 0; hf < 2; ++hf) {
                    f32x4 s[2];
                    const int dbase = q0 + qrow - k0 - 32 * hf - 8 * g4;
                    if (q0 - k0 - 32 * hf - 31 >= 128) { const float cb = TB[128]; s[0] = (f32x4){cb, cb, cb, cb}; s[1] = s[0]; }
                    else {
#pragma unroll
                        for (int t = 0; t < 2; ++t)
#pragma unroll
                            for (int r = 0; r < 4; ++r) { const int d0 = dbase - 4 * t - r; const float b0 = TB[min(max(d0, 0), 128)]; s[t][r] = d0 < 0 ? -INFINITY : b0; }
                    }
                    SB(); LDK(Y, hf, 1); SB();
                    MMK(X, 0); SB();
                    LDV(X, hf, 0); SB();
                    MMK(Y, 1); SB();
                    float mx = fmaxf(fmaxf(fmaxf(s[0][0], s[0][1]), fmaxf(s[0][2], s[0][3])), fmaxf(fmaxf(s[1][0], s[1][1]), fmaxf(s[1][2], s[1][3]))) * c1;
                    if (__any(mx > mrun + 12.0f)) {
                        { auto r1 = __builtin_amdgcn_permlane16_swap(__float_as_uint(mx), __float_as_uint(mx), false, false); mx = fmaxf(__uint_as_float(r1[0]), __uint_as_float(r1[1]));
                          auto r2 = __builtin_amdgcn_permlane32_swap(__float_as_uint(mx), __float_as_uint(mx), false, false); mx = fmaxf(__uint_as_float(r2[0]), __uint_as_float(r2[1])); }
                        const float mnew = fmaxf(mrun, mx); const float alpha = __builtin_amdgcn_exp2f(mrun - mnew); mrun = mnew; lrun *= alpha;
#pragma unroll
                        for (int eb = 0; eb < 16; ++eb) o[eb] = o[eb] * alpha; }
                    float p[8];
#pragma unroll
                    for (int t = 0; t < 2; ++t)
#pragma unroll
                        for (int r = 0; r < 4; ++r) p[4 * t + r] = __builtin_amdgcn_exp2f(s[t][r] * c1 - mrun);
                    lrun += ((p[0] + p[1]) + (p[2] + p[3])) + ((p[4] + p[5]) + (p[6] + p[7]));
                    v4u pk = {cvtpk(p[0], p[1]), cvtpk(p[2], p[3]), cvtpk(p[4], p[5]), cvtpk(p[6], p[7])}; const bf16x8 pb = __builtin_bit_cast(bf16x8, pk);
                    SB(); LDV(Y, hf, 1); SB();
                    MMV(X, 0); SB();
                    LDV(X, hf, 2); SB();
                    MMV(Y, 1); SB();
                    LDV(Y, hf, 3); SB();
                    MMV(X, 2); SB();
                    if (hf == 0) { LDK(X, 1, 0); SB(); }
                    MMV(Y, 3); SB();
                }
#undef LDK
#undef LDV
#undef MMK
#undef MMV
            }
#undef AT_DMA
            float lsum = lrun + __shfl_xor(lrun, 16); lsum += __shfl_xor(lsum, 32); const float inv = 1.0f / lsum;
            int lz = lane; asm volatile("" : "+v"(lz)); const int gz = lz >> 4, iz = lz & 15;
            __syncthreads();
            if (mh == 1) {
#pragma unroll
                for (int eb = 0; eb < 16; ++eb)
#pragma unroll
                    for (int r = 0; r < 4; ++r) XO[(((w - 4) * 64) + eb * 4 + r) * 64 + lz] = o[eb][r] * inv; }
            __syncthreads();
            if (mh == 0) { const float lam = LAMS[0]; float ss = 0.f;
#pragma unroll
                for (int eb = 0; eb < 16; ++eb)
#pragma unroll
                    for (int r = 0; r < 4; ++r) { const float vv = o[eb][r] * inv - lam * XO[((w * 64) + eb * 4 + r) * 64 + lz]; o[eb][r] = vv; ss += vv * vv; }
                ss += __shfl_xor(ss, 16); ss += __shfl_xor(ss, 32);
                const float rstd = (1.0f - LAMBDA_INIT) / sqrtf(ss * (1.f / 256.f) + EPS);
                bf16* op = O2 + ((size_t)b * SEQ + q0 + 16 * qb4 + iz) * D + h * 256 + 8 * gz;
#pragma unroll
                for (int pp = 0; pp < 8; ++pp) { const int e = 32 * pp + 8 * gz; const f32x4 g0 = *(const f32x4*)(subg + e), g1 = *(const f32x4*)(subg + e + 4);
                    v4u ov; ov.x = cvtpk(o[2 * pp][0] * rstd * g0[0], o[2 * pp][1] * rstd * g0[1]); ov.y = cvtpk(o[2 * pp][2] * rstd * g0[2], o[2 * pp][3] * rstd * g0[3]);
                    ov.z = cvtpk(o[2 * pp + 1][0] * rstd * g1[0], o[2 * pp + 1][1] * rstd * g1[1]); ov.w = cvtpk(o[2 * pp + 1][2] * rstd * g1[2], o[2 * pp + 1][3] * rstd * g1[3]);
                    *(v4u*)(op + 32 * pp) = ov; } }
        }
    }
}

struct Args { const float* in[22]; float* out; unsigned char* ws; };
__global__ void __launch_bounds__(NWAVES * 64, 2) yoco_fwd(Args args) {
    extern __shared__ __attribute__((aligned(16))) unsigned char lds_raw[];
    cg::grid_group grid = cg::this_grid();
    const ldsp lds = (ldsp)lds_raw;
    const int tid = threadIdx.x, lane = tid & 63, wave = __builtin_amdgcn_readfirstlane(tid >> 6);
    const int G = gridDim.x, bx = blockIdx.x; const int vcu = (G % 8 == 0) ? (bx % 8) * (G / 8) + bx / 8 : bx;
    const int gw = vcu * NWAVES + wave, NGW = G * NWAVES;
    unsigned char* ws = args.ws;
    const float* x = args.in[0]; const float* relb = args.in[1]; const float* kv_g = args.in[2]; const float* w_kv = args.in[3]; const float* w_in = args.in[4];
    const float* w_fg = args.in[5]; const float* b_fg = args.in[6]; const float* gla_ng = args.in[7]; const float* gla_wout = args.in[8]; const float* w_q = args.in[9];
    const float* lq1 = args.in[10]; const float* lk1 = args.in[11]; const float* lq2 = args.in[12]; const float* lk2 = args.in[13]; const float* subg = args.in[14];
    const float* diff_wout = args.in[15]; const float* pre_mix = args.in[16]; const float* post_mix = args.in[17]; const float* pre_ffn = args.in[18]; const float* post_ffn = args.in[19];
    const float* w_gu = args.in[20]; const float* w_dn = args.in[21];
    float* out = args.out;
    bf16* WG = (bf16*)(ws + WS_WG); bf16* WINA = (bf16*)(ws + WS_WINA); bf16* WINV = (bf16*)(ws + WS_WINV); bf16* WOUTA = (bf16*)(ws + WS_WOUTA);
    bf16* WGU0 = (bf16*)(ws + WS_WGU0); bf16* WGU1 = (bf16*)(ws + WS_WGU1); bf16* WDN0 = (bf16*)(ws + WS_WDN0); bf16* WDN1 = (bf16*)(ws + WS_WDN1);
    bf16* WKQ = (bf16*)(ws + WS_WKQ); bf16* WV = (bf16*)(ws + WS_WV); bf16* WOUTB = (bf16*)(ws + WS_WOUTB);
    bf16* BUFA = (bf16*)(ws + WS_BUFA); bf16* XN0 = (bf16*)(ws + WS_XN0); float* SQ0 = (float*)(ws + WS_SQ0); bf16* BUFB = (bf16*)(ws + WS_BUFB); float* GLR = (float*)(ws + WS_GLR); float* DECg = (float*)(ws + WS_DEC); bf16* ATTg = (bf16*)(ws + WS_ATT);
    bf16* PROJ = (bf16*)(ws + WS_R1); bf16* VTg = (bf16*)(ws + WS_VT); bf16* QDg = (bf16*)(ws + WS_QD); bf16* KETg = (bf16*)(ws + WS_KET); bf16* ACT = (bf16*)(ws + WS_R1); float* RS = (float*)(ws + WS_RS); bf16* O2B = (bf16*)(ws + WS_QD);

    for (int u = tid; u < 16; u += NWAVES * 64) ((LAS unsigned*)(lds + MISC_OFF))[u] = 0u;
    __syncthreads();
    XcdBarrier xbar = xcd_barrier_post((unsigned*)(ws + WS_CTL) + 1024, (volatile LAS unsigned*)(lds + MISC_OFF));
#define GSYNC() xcd_barrier(xbar)
    {
        LAS float* scr = (LAS float*)(lds + wave * 17408);
        constexpr int NITEMS = (2048 / 64) * ((8 * 2048) / 64) + 2 * (2048 / 64) * (11264 / 64) + 2 * (5632 / 64) * (2048 / 64);
#define SEG(W_, ldw_, col0_, K_, ncols_, gain_, dst_, mode_) if (!found_) { const int nblk_ = (ncols_) / 64, cnt_ = ((K_) / 64) * nblk_; if (r_ < cnt_) { const int kb_ = r_ / nblk_, nb_ = r_ % nblk_; \
            const float* gp_ = (gain_); dref_.src = (W_) + (size_t)(64 * kb_) * (ldw_) + (col0_) + 64 * nb_; dref_.gain = gp_ ? gp_ + 64 * kb_ : nullptr; dref_.dst = (dst_) + 64 * kb_; dref_.ldw = (ldw_); dref_.K = (K_); dref_.mode = (mode_); dref_.n0 = 64 * nb_; found_ = true; } else r_ -= cnt_; }
#define P0_DECODE(it_, dd_) do { int r_ = (it_); bool found_ = false; P0Desc& dref_ = (dd_); \
            SEG(w_gu, 11264, 0, 2048, 11264, pre_ffn, WGU0, 1) \
            SEG(w_gu + (size_t)2048 * 11264, 11264, 0, 2048, 11264, pre_ffn + D, WGU1, 1) \
            SEG(w_dn, 2048, 0, 5632, 2048, (const float*)nullptr, WDN0, 0) \
            SEG(w_dn + (size_t)5632 * 2048, 2048, 0, 5632, 2048, (const float*)nullptr, WDN1, 0) \
            SEG(w_in, GLA_IN, 0, 2048, 2048, pre_mix, WINA, 0) \
            SEG(w_in, GLA_IN, 4096, 2048, 2048, pre_mix, WINA + (size_t)2048 * 2048, 0) \
            SEG(w_in, GLA_IN, 2048, 2048, 2048, pre_mix, WINV, 0) \
            SEG(gla_wout, 2048, 0, 2048, 2048, (const float*)nullptr, WOUTA, 0) \
            SEG(w_kv, 4096, 0, 2048, 2048, kv_g, WKQ, 0) \
            SEG(w_kv, 4096, 2048, 2048, 2048, kv_g, WV, 0) \
            SEG(w_q, 2048, 0, 2048, 2048, pre_mix + D, WKQ + (size_t)2048 * 2048, 0) \
            SEG(diff_wout, 2048, 0, 2048, 2048, (const float*)nullptr, WOUTB, 0) } while (0)
        if (gw < NITEMS) {
            int it = gw; P0Desc cur, nxt; f32x4 R[16];
            P0_DECODE(it, cur); p0_load(cur, R, lane);
            for (;;) {
                p0_to_lds(R, scr, lane);
                const int nit = it + NGW; const bool more = nit < NITEMS;
                if (more) { P0_DECODE(nit, nxt); p0_load(nxt, R, lane); }
                asm volatile("s_waitcnt lgkmcnt(0)" ::: "memory");
                p0_emit(cur, scr, lane);
                asm volatile("s_waitcnt lgkmcnt(0)" ::: "memory");
                if (!more) break;
                cur = nxt; it = nit;
            }
        }
#undef SEG
#undef P0_DECODE
        for (int e = gw * 64 + lane; e < 16 * 2048; e += NGW * 64) { const int r = e >> 11, k = e & 2047; WG[e] = (bf16)(cvtpk(pre_mix[k] * w_in[(size_t)k * GLA_IN + 6144 + r], 0.f) & 0xffffu); }
        for (int m = 2 * gw; m < M; m += 2 * NGW) {
            const f32x4* xr0 = (const f32x4*)(x + (size_t)m * D) + lane; const f32x4* xr1 = xr0 + D / 4;
            f32x4 v0[8], v1[8]; float s0 = 0.f, s1 = 0.f;
#pragma unroll
            for (int j = 0; j < 8; ++j) v0[j] = __builtin_nontemporal_load(xr0 + 64 * j);
#pragma unroll
            for (int j = 0; j < 8; ++j) v1[j] = __builtin_nontemporal_load(xr1 + 64 * j);
#pragma unroll
            for (int j = 0; j < 8; ++j) { s0 += (v0[j].x * v0[j].x + v0[j].y * v0[j].y) + (v0[j].z * v0[j].z + v0[j].w * v0[j].w); s1 += (v1[j].x * v1[j].x + v1[j].y * v1[j].y) + (v1[j].z * v1[j].z + v1[j].w * v1[j].w); }
            const float r0 = 1.0f / sqrtf(wave_sum(s0) * (1.f / D) + EPS), r1 = 1.0f / sqrtf(wave_sum(s1) * (1.f / D) + EPS);
            v2u* o0 = (v2u*)(XN0 + (size_t)m * D) + lane; v2u* o1 = o0 + D / 4;
            if (lane == 0) { SQ0[m] = 1.0f / r0; SQ0[m + 1] = 1.0f / r1; }
#pragma unroll
            for (int j = 0; j < 8; ++j) { v2u w; w.x = cvtpk(v0[j].x * r0, v0[j].y * r0); w.y = cvtpk(v0[j].z * r0, v0[j].w * r0); o0[64 * j] = w; }
#pragma unroll
            for (int j = 0; j < 8; ++j) { v2u w; w.x = cvtpk(v1[j].x * r1, v1[j].y * r1); w.y = cvtpk(v1[j].z * r1, v1[j].w * r1); o1[64 * j] = w; }
        }
    }
    if (gridDim.y == 4242u) grid.sync();
    GSYNC();
    {
        glr_phase(lds, XN0, WG, GLR, G, tid);
        { pg8::Gemm g{XN0, WINA, M, 4096, D}; pg8::StaticOrder S; S.init(M, 4096, G, bx); pg8::EpiBf16<0> E{PROJ, 4096, nullptr, 0, 0, 1.f};
          pg8::gemm_phase<pg8::EpiBf16<0>, pg8::StaticOrder, true, true>(lds, g, S, E); }
        { pg8::Gemm g{WINV, XN0, 2048, M, D}; pg8::StaticOrder S; S.init(2048, M, G, bx); pg8::EpiBf16<0> E{VTg, M, nullptr, 0, 0, 1.f};
          pg8::gemm_phase<pg8::EpiBf16<0>, pg8::StaticOrder, true, true>(lds, g, S, E); }
    }
    GSYNC();
#ifndef SKIP_G1
    gla_pre_phase(lds, PROJ, GLR, w_fg, b_fg, QDg, KETg, ATTg, DECg, vcu, G, tid);
#endif
    GSYNC();
#ifndef SKIP_G2
    gla_scan_phase(lds, QDg, KETg, ATTg, DECg, VTg, BUFB, vcu, G, tid);
#endif
    GSYNC();
    gla_gate_phase(BUFB, PROJ, gla_ng, BUFA, gw, NGW, lane);
    GSYNC();
    { pg8::Gemm g{BUFA, WOUTA, M, D, D}; pg8::StaticOrder S; S.init(M, D, G, bx); pg8::EpiBf16<0> E{BUFB, D, nullptr, 0, 0, 1.f};
      pg8::gemm_phase<pg8::EpiBf16<0>, pg8::StaticOrder, true, true>(lds, g, S, E); }
    GSYNC();
    norm_res_phase<false, false>(XN0, BUFB, post_mix, BUFA, RS, SQ0, gw, NGW, lane);
    GSYNC();
    { pg8::Gemm g{BUFA, WGU0, M, 2 * DFF, D}; pg8::StaticOrder S; S.init(M, 2 * DFF, G, bx); pg8::EpiSwiglu E{ACT, DFF, RS};
      pg8::gemm_phase<pg8::EpiSwiglu, pg8::StaticOrder, true, true>(lds, g, S, E); }
    GSYNC();
    { pg8::Gemm g{ACT, WDN0, M, D, DFF}; pg8::StaticOrder S; S.init(M, D, G, bx); pg8::EpiBf16<0> E{BUFB, D, nullptr, 0, 0, 1.f};
      pg8::gemm_phase<pg8::EpiBf16<0>, pg8::StaticOrder, true, true>(lds, g, S, E); }
    GSYNC();
    norm_res_phase<false, false>(BUFA, BUFB, post_ffn, BUFA, RS, nullptr, gw, NGW, lane);
    GSYNC();
    {
        { pg8::Gemm g{BUFA, WKQ, M, 4096, D}; pg8::StaticOrder S; S.init(M, 4096, G, bx); pg8::EpiBf16S E{PROJ, 4096, RS, nullptr};
          pg8::gemm_phase<pg8::EpiBf16S, pg8::StaticOrder, true, true>(lds, g, S, E); }
        { pg8::Gemm g{WV, BUFA, 2048, M, D}; pg8::StaticOrder S; S.init(2048, M, G, bx); pg8::EpiBf16S E{VTg, M, nullptr, RS};
          pg8::gemm_phase<pg8::EpiBf16S, pg8::StaticOrder, true, true>(lds, g, S, E); }
    }
    GSYNC();
#ifndef SKIP_AT
    attn_phase(lds, PROJ, VTg, relb, lq1, lk1, lq2, lk2, subg, O2B, vcu, G, tid);
#endif
    GSYNC();
    { pg8::Gemm g{O2B, WOUTB, M, D, D}; pg8::StaticOrder S; S.init(M, D, G, bx); pg8::EpiBf16<0> E{BUFB, D, nullptr, 0, 0, 1.f};
      pg8::gemm_phase<pg8::EpiBf16<0>, pg8::StaticOrder, true, true>(lds, g, S, E); }
    GSYNC();
    norm_res_phase<false, false>(BUFA, BUFB, post_mix + D, BUFA, RS, nullptr, gw, NGW, lane);
    GSYNC();
    { pg8::Gemm g{BUFA, WGU1, M, 2 * DFF, D}; pg8::StaticOrder S; S.init(M, 2 * DFF, G, bx); pg8::EpiSwiglu E{ACT, DFF, RS};
      pg8::gemm_phase<pg8::EpiSwiglu, pg8::StaticOrder, true, true>(lds, g, S, E); }
    GSYNC();
    { pg8::Gemm g{ACT, WDN1, M, D, DFF}; pg8::StaticOrder S; S.init(M, D, G, bx); pg8::EpiBf16<0> E{BUFB, D, nullptr, 0, 0, 1.f};
      pg8::gemm_phase<pg8::EpiBf16<0>, pg8::StaticOrder, true, true>(lds, g, S, E); }
    GSYNC();
    norm_res_phase<false, true>(BUFA, BUFB, post_ffn + D, out, nullptr, nullptr, gw, NGW, lane);
}

extern "C" void kernel_launch(void* const* d_in, const int* in_sizes, int n_in, void* d_out, int out_size, void* d_ws, size_t ws_size, hipStream_t stream) {
    static int grid = 0;
    if (grid == 0) {
        if (n_in != 22 || out_size != M * D || ws_size < WS_END) { fprintf(stderr, "kernel_launch: unexpected shapes (n_in %d out %d ws %zu need %zu)\n", n_in, out_size, ws_size, (size_t)WS_END); grid = -1; return; }
        int dev = 0, cus = 0, per_cu = 0;
        hipGetDevice(&dev); hipDeviceGetAttribute(&cus, hipDeviceAttributeMultiprocessorCount, dev);
        hipFuncSetAttribute((const void*)yoco_fwd, hipFuncAttributeMaxDynamicSharedMemorySize, LDS_BYTES);
        hipOccupancyMaxActiveBlocksPerMultiprocessor(&per_cu, (const void*)yoco_fwd, NWAVES * 64, LDS_BYTES);
        if (per_cu < 1) per_cu = 1;
        (void)hipGetLastError();
        grid = cus;
    }
    if (grid < 0) return;
    Args a{};
    for (int i = 0; i < 22; ++i) a.in[i] = (const float*)d_in[i];
    a.out = (float*)d_out; a.ws = (unsigned char*)d_ws;
    if (hipMemsetAsync((char*)d_ws + WS_CTL, 0, 20480, stream) != hipSuccess) { fprintf(stderr, "memset failed\n"); return; }
    void* kargs[] = {&a};
    hipError_t e = hipLaunchCooperativeKernel((const void*)yoco_fwd, dim3(grid), dim3(NWAVES * 64), kargs, LDS_BYTES, stream);
    if (e != hipSuccess) fprintf(stderr, "cooperative launch failed: %s (grid %d)\n", hipGetErrorString(e), grid);
}
```
